# Optimizing an MI355X kernel written in HIP

```python
import math
import jax, jax.numpy as jnp
from jax import lax
import numpy as np

D_MODEL = 1024
BATCH = 2
SEQ = 16384
DEPTH = 2

CHUNK = 64
Q_BLOCK = 128
HEAD_DIM = 64
A_HEADS = 4
A_VDIM = 2 * HEAD_DIM
B_HEADS = 8
B_LEFT_CHUNKS = 8
B_BAND = (B_LEFT_CHUNKS + 1) * CHUNK
B_REL_CLIP = 128
C_HEADS = 8
T5_BUCKETS = 32
T5_MAX_DIST = 2048

N_BRANCH = 3
A_QK_W = A_HEADS * 2 * HEAD_DIM
A_V_W = A_HEADS * A_VDIM
B_W = B_HEADS * HEAD_DIM
C_W = C_HEADS * HEAD_DIM
IN_WIDTH = 2 * A_QK_W + A_V_W + 3 * B_W + 3 * C_W + C_HEADS + N_BRANCH * D_MODEL
D_FF = -(-8 * D_MODEL // (3 * 256)) * 256
RMS_EPS = 1e-6
NEG_INF = -1e30

kernel_name = "hybrid_gated_diff_band_forget_block"


def _split_points():
    widths = [A_QK_W, A_QK_W, A_V_W, B_W, B_W, B_W, C_W, C_W, C_W, C_HEADS, N_BRANCH * D_MODEL]
    pts, acc = [], 0
    for w in widths[:-1]:
        acc += w
        pts.append(acc)
    return pts


def _rmsnorm(x, g):
    xf = x.astype(jnp.float32)
    y = xf * lax.rsqrt(jnp.mean(xf * xf, axis=-1, keepdims=True) + RMS_EPS)
    return (y * g.astype(jnp.float32)).astype(x.dtype)


def _t5_bucket(rel):
    nb = T5_BUCKETS // 2
    max_exact = nb // 2
    n = jnp.abs(rel)
    nf = jnp.maximum(n, 1).astype(jnp.float32)
    large = max_exact + (jnp.log(nf / max_exact) / math.log(T5_MAX_DIST / max_exact) * (nb - max_exact)).astype(jnp.int32)
    large = jnp.minimum(large, nb - 1)
    return jnp.where(rel > 0, nb, 0) + jnp.where(n < max_exact, n, large)


def _diff_attention(q, k, v, t5_table, lam, lam_init, subln_g):
    b_, s_, h_ = q.shape[0], q.shape[1], q.shape[2]
    n_blk = s_ // Q_BLOCK
    scale = HEAD_DIM ** -0.5
    k_pos = jnp.arange(s_)
    k_chunk = k_pos // CHUNK
    qb = q.reshape(b_, n_blk, Q_BLOCK, h_, 2, HEAD_DIM).swapaxes(0, 1)

    def step(args):
        q_blk, i = args
        q_pos = i * Q_BLOCK + jnp.arange(Q_BLOCK)
        allowed = k_chunk[None, :] <= (q_pos // CHUNK)[:, None]
        bias = jnp.moveaxis(t5_table[_t5_bucket(k_pos[None, :] - q_pos[:, None])], -1, 0)
        s = jnp.einsum("bqhmd,bkhmd->bhmqk", q_blk, k).astype(jnp.float32) * scale
        s = jnp.where(allowed, s + bias.astype(jnp.float32)[None, :, None], NEG_INF)
        p = jax.nn.softmax(s, axis=-1)
        a = p[:, :, 0] - lam * p[:, :, 1]
        return jnp.einsum("bhqk,bkhe->bqhe", a.astype(v.dtype), v)

    o = lax.map(step, (qb, jnp.arange(n_blk)))
    o = o.swapaxes(0, 1).reshape(b_, s_, h_, A_VDIM)
    o = _rmsnorm(o, subln_g) * (1.0 - lam_init)
    return o.reshape(b_, s_, h_ * A_VDIM)


def _chunk_band_attention(q, k, v, rel_table):
    b_, s_, h_, d_ = q.shape
    n_chunk = s_ // CHUNK
    pad = B_LEFT_CHUNKS * CHUNK
    scale = d_ ** -0.5
    kp = jnp.pad(k, ((0, 0), (pad, 0), (0, 0), (0, 0)))
    vp = jnp.pad(v, ((0, 0), (pad, 0), (0, 0), (0, 0)))
    qi = jnp.arange(CHUNK)
    kj = jnp.arange(B_BAND)
    rel = jnp.clip((kj[None, :] - pad) - qi[:, None], -B_REL_CLIP, CHUNK - 1) + B_REL_CLIP
    bias = jnp.moveaxis(rel_table[rel], -1, 0).astype(jnp.float32)
    qc = q.reshape(b_, n_chunk, CHUNK, h_, d_).swapaxes(0, 1)

    def step(args):
        q_c, c = args
        start = c * CHUNK
        k_band = lax.dynamic_slice_in_dim(kp, start, B_BAND, axis=1)
        v_band = lax.dynamic_slice_in_dim(vp, start, B_BAND, axis=1)
        valid = (start - pad + kj) >= 0
        s = jnp.einsum("bqhd,bkhd->bhqk", q_c, k_band).astype(jnp.float32) * scale
        s = jnp.where(valid, s + bias, NEG_INF)
        p = jax.nn.softmax(s, axis=-1)
        return jnp.einsum("bhqk,bkhd->bqhd", p.astype(v.dtype), v_band)

    o = lax.map(step, (qc, jnp.arange(n_chunk)))
    return o.swapaxes(0, 1).reshape(b_, s_, h_ * d_)


def _forgetting_attention(q, k, v, log_f):
    b_, s_, h_, d_ = q.shape
    n_blk = s_ // Q_BLOCK
    scale = d_ ** -0.5
    c = jnp.cumsum(log_f, axis=1)
    c_k = c.transpose(0, 2, 1)
    k_pos = jnp.arange(s_)
    qb = q.reshape(b_, n_blk, Q_BLOCK, h_, d_).swapaxes(0, 1)
    cb = c.reshape(b_, n_blk, Q_BLOCK, h_).swapaxes(0, 1)

    def step(args):
        q_blk, c_blk, i = args
        q_pos = i * Q_BLOCK + jnp.arange(Q_BLOCK)
        causal = k_pos[None, :] <= q_pos[:, None]
        s = jnp.einsum("bqhd,bkhd->bhqk", q_blk, k).astype(jnp.float32) * scale
        s = s + c_blk.transpose(0, 2, 1)[..., None] - c_k[:, :, None, :]
        s = jnp.where(causal, s, NEG_INF)
        p = jax.nn.softmax(s, axis=-1)
        return jnp.einsum("bhqk,bkhd->bqhd", p.astype(v.dtype), v)

    o = lax.map(step, (qb, cb, jnp.arange(n_blk)))
    return o.swapaxes(0, 1).reshape(b_, s_, h_ * d_)


def setup_inputs(seed: int = 0) -> dict:
    key = jax.random.key(seed)
    ks = jax.random.split(key, 20)
    f32 = jnp.float32
    nrm = lambda k, shape, s: jax.random.normal(k, shape, f32) * s
    return {
        "x": nrm(ks[0], (BATCH, SEQ, D_MODEL), 1.0),
        "norm_mix_g": 1.0 + nrm(ks[1], (DEPTH, D_MODEL), 0.05),
        "w_in": nrm(ks[2], (DEPTH, D_MODEL, IN_WIDTH), D_MODEL ** -0.5),
        "b_forget": jax.random.uniform(ks[3], (DEPTH, C_HEADS), f32, 2.0, 6.0),
        "diff_lambda": nrm(ks[4], (DEPTH, 4, HEAD_DIM), 0.1),
        "diff_subln_g": 1.0 + nrm(ks[5], (DEPTH, A_VDIM), 0.05),
        "t5_table": nrm(ks[6], (T5_BUCKETS, A_HEADS), 0.5),
        "b_rel_table": nrm(ks[7], (DEPTH, B_REL_CLIP + CHUNK, B_HEADS), 0.5),
        "w_br_a": nrm(ks[8], (DEPTH, A_V_W, D_MODEL), A_V_W ** -0.5),
        "w_br_b": nrm(ks[9], (DEPTH, B_W, D_MODEL), B_W ** -0.5),
        "w_br_c": nrm(ks[10], (DEPTH, C_W, D_MODEL), C_W ** -0.5),
        "w_out": nrm(ks[11], (DEPTH, D_MODEL, D_MODEL), D_MODEL ** -0.5),
        "norm_ffn_g": 1.0 + nrm(ks[12], (DEPTH, D_MODEL), 0.05),
        "w_gate_up": nrm(ks[13], (DEPTH, D_MODEL, 2 * D_FF), D_MODEL ** -0.5),
        "w_down": nrm(ks[14], (DEPTH, D_FF, D_MODEL), D_FF ** -0.5),
        "final_norm_g": 1.0 + nrm(ks[15], (D_MODEL,), 0.05),
    }


def reference(x, norm_mix_g, w_in, b_forget, diff_lambda, diff_subln_g, t5_table, b_rel_table,
              w_br_a, w_br_b, w_br_c, w_out, norm_ffn_g, w_gate_up, w_down, final_norm_g):
    b_, s_, _ = x.shape
    splits = _split_points()
    for l in range(DEPTH):
        h = _rmsnorm(x, norm_mix_g[l])
        proj = h @ w_in[l]
        a_q, a_k, a_v, b_q, b_k, b_v, c_q, c_k, c_v, c_f, gates = jnp.split(proj, splits, axis=-1)

        lam_init = 0.8 - 0.6 * math.exp(-0.3 * l)
        lp = diff_lambda[l].astype(jnp.float32)
        lam = jnp.exp(jnp.sum(lp[0] * lp[1])) - jnp.exp(jnp.sum(lp[2] * lp[3])) + lam_init
        o_a = _diff_attention(a_q.reshape(b_, s_, A_HEADS, 2, HEAD_DIM),
                              a_k.reshape(b_, s_, A_HEADS, 2, HEAD_DIM),
                              a_v.reshape(b_, s_, A_HEADS, A_VDIM),
                              t5_table, lam, lam_init, diff_subln_g[l])

        o_b = _chunk_band_attention(b_q.reshape(b_, s_, B_HEADS, HEAD_DIM),
                                    b_k.reshape(b_, s_, B_HEADS, HEAD_DIM),
                                    b_v.reshape(b_, s_, B_HEADS, HEAD_DIM),
                                    b_rel_table[l])

        log_f = jax.nn.log_sigmoid((c_f + b_forget[l]).astype(jnp.float32))
        o_c = _forgetting_attention(c_q.reshape(b_, s_, C_HEADS, HEAD_DIM),
                                    c_k.reshape(b_, s_, C_HEADS, HEAD_DIM),
                                    c_v.reshape(b_, s_, C_HEADS, HEAD_DIM),
                                    log_f)

        g = jax.nn.sigmoid(gates.astype(jnp.float32)).astype(x.dtype).reshape(b_, s_, N_BRANCH, D_MODEL)
        merged = (g[:, :, 0] * (o_a @ w_br_a[l])
                  + g[:, :, 1] * (o_b @ w_br_b[l])
                  + g[:, :, 2] * (o_c @ w_br_c[l]))
        x = x + merged @ w_out[l]

        h = _rmsnorm(x, norm_ffn_g[l])
        gt, up = jnp.split(h @ w_gate_up[l], 2, axis=-1)
        x = x + (jax.nn.silu(gt) * up) @ w_down[l]
    return _rmsnorm(x, final_norm_g)
```

```cpp
#include <hip/hip_runtime.h>
#include <hip/hip_cooperative_groups.h>
#include <hip/hip_bf16.h>
#include <cstdio>
#include <cstdint>
#include <cmath>
namespace cg = cooperative_groups;

#ifndef PH_MASK
#define PH_MASK 0x1ff
#endif
#ifndef MK_ONE_LAUNCH
#define MK_ONE_LAUNCH 1
#endif

#define LAS __attribute__((address_space(3)))
#define DI __device__ __forceinline__
typedef unsigned short bf16_t;
typedef short bf16x8 __attribute__((ext_vector_type(8)));
typedef short s16x4 __attribute__((ext_vector_type(4)));
typedef float f32x4 __attribute__((ext_vector_type(4)));
typedef float f32x16 __attribute__((ext_vector_type(16)));
typedef unsigned u32x4 __attribute__((ext_vector_type(4)));
typedef unsigned u32x2 __attribute__((ext_vector_type(2)));
typedef float f32x2_t __attribute__((ext_vector_type(2)));
typedef __bf16 bf16x2_t __attribute__((ext_vector_type(2)));
DI int opaque_tid() { int t = threadIdx.x; asm volatile("" : "+v"(t)); return t; }

constexpr int D = 1024, BATCH = 2, SEQ = 16384, DEPTH = 2, M = BATCH * SEQ;
constexpr int INW = 7688, DFF = 2816;
constexpr int PITCH = 1536;
constexpr int NQKV = 4864;
constexpr float RMS_EPS = 1e-6f;
constexpr float LOG2E = 1.4426950408889634f;
constexpr float C2 = 0.125f * LOG2E;

constexpr size_t MiB = 1u << 20;
constexpr size_t WS_CTL = 0, CTL_BYTES = 1 * MiB;
constexpr size_t WS_ORDER = 1 * MiB;
constexpr size_t WS_LF = 2 * MiB;
constexpr size_t WS_CK = 3 * MiB;
constexpr size_t WS_KX = 4 * MiB;
constexpr size_t WS_W = 8 * MiB;
constexpr size_t W_QKV = 0, W_G = 10 * MiB, W_BR = 16 * MiB, W_OUT = 19 * MiB, W_GU = 21 * MiB, W_DN = 32 * MiB, W_LAYER = 38 * MiB;
constexpr size_t WS_XB = 84 * MiB;
constexpr size_t WS_QP = 148 * MiB, WS_KP = 244 * MiB, WS_VP = 340 * MiB;
constexpr size_t WS_MG = 436 * MiB;
constexpr size_t WS_G = WS_KP;
constexpr size_t WS_HID = WS_KP;
constexpr size_t WS_END = 500 * MiB;
static_assert(WS_W + 2 * W_LAYER <= WS_XB, "weights fit");
constexpr int CW_QUEUE = 0;
constexpr int CW_BAR = 8192;
constexpr int CW_NRM = 1024;
constexpr int CW_RSS = 65536;

constexpr int NUNITS = 3072;

namespace pg8 {
constexpr int BM = 256, BK = 64, HALF = 128, HTB = HALF * BK * 2, STAGE_BYTES = 8 * HTB, NXCD = 8, WGM = 8;
__host__ __device__ __forceinline__ int lds_byte(int r, int c) { const int st = (r >> 4) * 2 + (c >> 5), rr = r & 15, cc = c & 31, ob = rr * 64 + cc * 2; return st * 1024 + (ob ^ (((ob >> 9) & 1) << 5)); }
__host__ __device__ __forceinline__ void stage_rc(int b, int& R, int& C) { const int st = b / 1024, sb = b % 1024, swz = sb ^ (((sb >> 9) & 1) << 5); R = (st >> 1) * 16 + swz / 64; C = (st & 1) * 32 + (swz % 64) / 2; }
__host__ __device__ __forceinline__ int perm32(int rho) { const int n = rho >> 4, i = rho & 15; return 8 * (i >> 2) + 4 * n + (i & 3); }

struct Unit { int pm, pn, aoff; };
struct Gemm { const bf16_t* A; const bf16_t* Bt; int M, N, K, lda, ldb; };

struct StaticOrder {
    int nM, nN, nwg, G, c;
    __device__ void init(int M_, int N_, int G_, int c_) { nM = M_ / BM; nN = N_ / BM; nwg = nM * nN; G = G_; c = c_; }
    __device__ bool tile(long L, int& pm, int& pn) const {
        if (L >= nwg) return false;
        int wgid = (int)L; { const int q = nwg / NXCD, r = nwg % NXCD, xcd = wgid % NXCD, off = wgid / NXCD; wgid = (xcd < r ? xcd * (q + 1) : r * (q + 1) + (xcd - r) * q) + off; }
        const int nig = WGM * nN, gid = wgid / nig, fm = gid * WGM, gsz = (nM - fm) < WGM ? (nM - fm) : WGM;
        pm = fm + ((wgid % nig) % gsz); pn = (wgid % nig) / gsz; return true;
    }
    __device__ bool next(int i, Unit& u) const { u.aoff = 0; return tile((long)i * G + c, u.pm, u.pn); }
};
struct BranchOrder {
    StaticOrder s;
    __device__ void init(int M_, int G_, int c_) { s.init(M_, 1024, G_, c_); }
    __device__ bool next(int i, Unit& u) const {
        const int br = i % 3; int pm, pn;
        if (!s.tile((long)(i / 3) * s.G + s.c, pm, pn)) return false;
        u.pm = pm; u.pn = br * 4 + pn; u.aoff = br * 512 * 2; return true;
    }
};

__device__ __forceinline__ unsigned cvt_pk_bf16(float lo, float hi) { unsigned r; asm volatile("v_cvt_pk_bf16_f32 %0, %1, %2" : "=v"(r) : "v"(lo), "v"(hi)); return r; }

template <class Epi, class Sched, bool ALIGN_EPI>
__device__ __forceinline__ void gemm_phase(LAS unsigned char* lds, const Gemm g, const Sched& S, const Epi& E) {
    const int tid = opaque_tid(), wid = __builtin_amdgcn_readfirstlane(tid >> 6), lane = tid & 63, wr = wid >> 2, wc = wid & 3, fr = lane & 15, fq = lane >> 4;
    const int K = g.K, nt = K / BK;
    unsigned voffA[2], voffB[2];
#pragma unroll
    for (int i = 0; i < 2; ++i) { int R, C; stage_rc(tid * 16 + i * 8192, R, C); const int Rb = Epi::PERM ? ((R & ~31) + perm32(R & 31)) : R;
        voffA[i] = (unsigned)(R * g.lda + C) * 2u; voffB[i] = (unsigned)(Rb * g.ldb + C) * 2u; }
    const size_t kstep = (size_t)(BK * 2);
    const size_t hstepA = (size_t)HALF * g.lda * 2, hstepB = (size_t)HALF * g.ldb * 2;
    const size_t tstepA = 2 * hstepA, tstepB = 2 * hstepB;
    const unsigned ldsw = (unsigned)wid * 1024u;
    const int aoff = lds_byte(wr * 64 + fr, fq * 8), boff = lds_byte(wc * 32 + fr, fq * 8);
#define PG8_SA(b, h) (((b) * 2 + (h)) * HTB)
#define PG8_SB(b, h) ((4 + (b) * 2 + (h)) * HTB)
#define PG8_STAGE(bufoff, gbase, voff) do { _Pragma("unroll") for (int _i = 0; _i < 2; ++_i) \
        __builtin_amdgcn_global_load_lds((const unsigned*)((const char*)(gbase) + (voff)[_i]), (LAS unsigned*)(lds + (bufoff) + ldsw + _i * 8192), 16, 0, 0); } while (0)
#define PG8_LDA(dst, b, h) do { _Pragma("unroll") for (int m = 0; m < 4; ++m) _Pragma("unroll") for (int k = 0; k < 2; ++k) dst[m][k] = *(const LAS bf16x8*)(lds + PG8_SA(b, h) + aoff + m * 2048 + k * 1024); } while (0)
#define PG8_LDB(dst, b, h) do { _Pragma("unroll") for (int n = 0; n < 2; ++n) _Pragma("unroll") for (int k = 0; k < 2; ++k) dst[n][k] = *(const LAS bf16x8*)(lds + PG8_SB(b, h) + boff + n * 2048 + k * 1024); } while (0)
#define PG8_MMA(ai, bj, At, Bt) do { __builtin_amdgcn_s_setprio(1); _Pragma("unroll") for (int m = 0; m < 4; ++m) _Pragma("unroll") for (int n = 0; n < 2; ++n) _Pragma("unroll") for (int k = 0; k < 2; ++k) \
        acc[ai][bj][m][n] = __builtin_amdgcn_mfma_f32_16x16x32_bf16(Bt[n][k], At[m][k], acc[ai][bj][m][n], 0, 0, 0); __builtin_amdgcn_s_setprio(0); } while (0)
#define PG8_WAIT_V(n) asm volatile("s_waitcnt vmcnt(" #n ")" ::: "memory")
#define PG8_WAIT_L(n) asm volatile("s_waitcnt lgkmcnt(" #n ")" ::: "memory")
#define PG8_BAR __builtin_amdgcn_s_barrier()
#define PG8_SCHED __builtin_amdgcn_sched_barrier(0)
    Unit cur, nxt; int ui = 0;
    if (!S.next(0, cur)) return;
    f32x4 acc[2][2][4][2];
#pragma unroll
    for (int a = 0; a < 2; ++a)
#pragma unroll
        for (int b = 0; b < 2; ++b)
#pragma unroll
            for (int m = 0; m < 4; ++m)
#pragma unroll
                for (int n = 0; n < 2; ++n) acc[a][b][m][n] = (f32x4){0.f, 0.f, 0.f, 0.f};
    bf16x8 At[4][2], B0[2][2], B1[2][2];
    const char* cA = (const char*)g.A + (size_t)cur.pm * tstepA + cur.aoff; const char* cB = (const char*)g.Bt + (size_t)cur.pn * tstepB;
    PG8_STAGE(PG8_SB(0, 0), cB, voffB); PG8_STAGE(PG8_SB(0, 1), cB + hstepB, voffB); PG8_STAGE(PG8_SA(0, 0), cA, voffA); PG8_STAGE(PG8_SA(0, 1), cA + hstepA, voffA);
    if (wr == 1) PG8_BAR;
    PG8_WAIT_V(2); PG8_BAR;
    PG8_STAGE(PG8_SB(1, 0), cB + kstep, voffB); PG8_STAGE(PG8_SA(1, 0), cA + kstep, voffA); PG8_STAGE(PG8_SB(1, 1), cB + hstepB + kstep, voffB);
    PG8_WAIT_V(6); PG8_BAR;
    for (;;) {
        const bool has_next = S.next(ui + 1, nxt);
        const char* nA = has_next ? (const char*)g.A + (size_t)nxt.pm * tstepA + nxt.aoff : cA; const char* nB = has_next ? (const char*)g.Bt + (size_t)nxt.pn * tstepB : cB;
        for (int t = 0; t < nt; t += 2) {
            const bool last = (t == nt - 2);
            const char* a1 = cA + (size_t)(t + 1) * kstep;
            const char* a2 = last ? nA : cA + (size_t)(t + 2) * kstep; const char* b2 = last ? nB : cB + (size_t)(t + 2) * kstep;
            const char* a3 = a2 + kstep; const char* b3 = b2 + kstep;
            PG8_LDB(B0, 0, 0); PG8_LDB(B1, 0, 1); PG8_SCHED; PG8_LDA(At, 0, 0); PG8_STAGE(PG8_SA(1, 1), a1 + hstepA, voffA);
            PG8_WAIT_V(8); PG8_WAIT_L(0); PG8_BAR; PG8_MMA(0, 0, At, B0); PG8_MMA(0, 1, At, B1); PG8_BAR; PG8_SCHED;
            PG8_LDA(At, 0, 1); PG8_STAGE(PG8_SB(0, 0), b2, voffB); PG8_STAGE(PG8_SB(0, 1), b2 + hstepB, voffB); PG8_STAGE(PG8_SA(0, 0), a2, voffA);
            PG8_WAIT_V(8); PG8_WAIT_L(0); PG8_BAR; PG8_MMA(1, 0, At, B0); PG8_MMA(1, 1, At, B1); PG8_BAR; PG8_SCHED;
            PG8_LDB(B0, 1, 0); PG8_LDB(B1, 1, 1); PG8_SCHED; PG8_LDA(At, 1, 0); PG8_STAGE(PG8_SA(0, 1), a2 + hstepA, voffA);
            PG8_WAIT_V(8); PG8_WAIT_L(0); PG8_BAR; PG8_MMA(0, 0, At, B0); PG8_MMA(0, 1, At, B1); PG8_BAR; PG8_SCHED;
            PG8_LDA(At, 1, 1); PG8_STAGE(PG8_SB(1, 0), b3, voffB); PG8_STAGE(PG8_SB(1, 1), b3 + hstepB, voffB); PG8_STAGE(PG8_SA(1, 0), a3, voffA);
            PG8_WAIT_V(8); PG8_WAIT_L(0); PG8_BAR; PG8_MMA(1, 0, At, B0); PG8_MMA(1, 1, At, B1); PG8_BAR; PG8_SCHED;
        }
        if constexpr (ALIGN_EPI) { if (wr == 0) PG8_BAR; }
        bool clear_acc = true;
        if constexpr (Epi::FUSE) clear_acc = E.fused(acc, cur, wr, wc, fr, fq); else E(acc, cur, wr, wc, fr, fq);
        if (!has_next) break;
        if (clear_acc) {
#pragma unroll
        for (int a = 0; a < 2; ++a)
#pragma unroll
            for (int b = 0; b < 2; ++b)
#pragma unroll
                for (int m = 0; m < 4; ++m)
#pragma unroll
                    for (int n = 0; n < 2; ++n) acc[a][b][m][n] = (f32x4){0.f, 0.f, 0.f, 0.f};
        }
        cur = nxt; cA = nA; cB = nB; ++ui;
        if constexpr (ALIGN_EPI) { if (wr == 1) PG8_BAR; }
    }
    PG8_WAIT_V(0);
    if constexpr (!ALIGN_EPI) { if (wr == 0) PG8_BAR; }
    PG8_BAR;
#undef PG8_SA
#undef PG8_SB
#undef PG8_STAGE
#undef PG8_LDA
#undef PG8_LDB
#undef PG8_MMA
#undef PG8_WAIT_V
#undef PG8_WAIT_L
#undef PG8_BAR
#undef PG8_SCHED
}

typedef const f32x4 (&AccRef)[2][2][4][2];
__device__ __forceinline__ float rstd_of(const float* rss, int row) { return __builtin_amdgcn_rsqf((float)((const unsigned*)rss)[row] * (1.0f / (256.0f * 1024.0f)) + RMS_EPS); }
__device__ __forceinline__ float sigmoidf_(float x) { return __builtin_amdgcn_rcpf(1.0f + __builtin_amdgcn_exp2f(-x * LOG2E)); }

__device__ __forceinline__ float bflo(unsigned w) { return __uint_as_float(w << 16); }
__device__ __forceinline__ float bfhi(unsigned w) { return __uint_as_float(w & 0xffff0000u); }
struct EpiQKV {
    static constexpr bool PERM = true, FUSE = false;
    bf16_t* Qp; const float* rss; float* LF; const float* bforget; unsigned* nrm;
    __device__ __forceinline__ void operator()(AccRef acc, const Unit& u, int wr, int wc, int fr, int fq) const {
        const int row0 = u.pm * BM + wr * 64 + fr;
        if (u.pn < 18) {
            const int plane = u.pn / 6, colt = (u.pn % 6) * 256; bf16_t* base = Qp + (size_t)plane * ((WS_KP - WS_QP) / 2);
            const float sc = plane == 0 ? C2 : 1.0f; const int col0 = colt + wc * 32 + 8 * fq;
            const bool donrm = (plane < 2) && (colt >= 1024);
            float nmax[2] = {0.f, 0.f};
#pragma unroll
            for (int ai = 0; ai < 2; ++ai)
#pragma unroll
                for (int m = 0; m < 4; ++m) { const int row = row0 + ai * HALF + m * 16; const float rs = rstd_of(rss, row) * sc; bf16_t* rowp = base + (size_t)row * PITCH + col0;
                    const int bb = row >> 14, sq = row & (SEQ - 1), tt = sq >> 6;
#pragma unroll
                    for (int bj = 0; bj < 2; ++bj) { const f32x4 v0 = acc[ai][bj][m][0] * rs, v1 = acc[ai][bj][m][1] * rs; u32x4 w;
                        w.x = cvt_pk_bf16(v0[0], v0[1]); w.y = cvt_pk_bf16(v0[2], v0[3]); w.z = cvt_pk_bf16(v1[0], v1[1]); w.w = cvt_pk_bf16(v1[2], v1[3]);
                        const int col = col0 + bj * HALF;
                        bf16_t* dst = rowp + bj * HALF;
                        if (plane == 1) dst = base + ((((size_t)(bb * 24 + (col >> 6)) * 256 + tt) * 8 + ((col & 63) >> 3)) * 64 + (sq & 63)) * 8;
                        if (plane == 2) dst = base + (((((size_t)(bb * 48 + (col >> 5)) * 256 + tt) * 4 + ((sq & 63) >> 4)) * 16 + (sq & 15)) * 32 + (col & 31));
                        *(u32x4*)dst = w;
                        if (donrm) { float ss = 0.f;
#pragma unroll
                            for (int j = 0; j < 4; ++j) { const float lo = bflo(w[j]), hi = bfhi(w[j]); ss += lo * lo + hi * hi; }
                            ss += __shfl_xor(ss, 16); ss += __shfl_xor(ss, 32); nmax[bj] = fmaxf(nmax[bj], ss); } } }
            if (donrm) {
#pragma unroll
                for (int bj = 0; bj < 2; ++bj) { float v = nmax[bj];
                    v = fmaxf(v, __shfl_xor(v, 1)); v = fmaxf(v, __shfl_xor(v, 2)); v = fmaxf(v, __shfl_xor(v, 4)); v = fmaxf(v, __shfl_xor(v, 8));
                    const int hc = colt - 1024 + bj * HALF + wc * 32;
                    if (fr == 0 && fq == 0) atomicMax(nrm + (((row0 >= SEQ ? 8 : 0) + (hc >> 6)) * 2 + plane) * 2 + ((hc >> 5) & 1), __float_as_uint(v)); } }
        } else if (wc == 0 && fq == 0) {
            f32x4 b0 = *(const f32x4*)(bforget), b1 = *(const f32x4*)(bforget + 4);
#pragma unroll
            for (int ai = 0; ai < 2; ++ai)
#pragma unroll
                for (int m = 0; m < 4; ++m) { const int row = row0 + ai * HALF + m * 16; const float rs = rstd_of(rss, row);
                    f32x4 z0 = acc[ai][0][m][0] * rs + b0, z1 = acc[ai][0][m][1] * rs + b1, o0, o1;
#pragma unroll
                    for (int j = 0; j < 4; ++j) {
                        o0[j] = fminf(z0[j], 0.f) * LOG2E - __builtin_amdgcn_logf(1.0f + __builtin_amdgcn_exp2f(-fabsf(z0[j]) * LOG2E)); o1[j] = fminf(z1[j], 0.f) * LOG2E - __builtin_amdgcn_logf(1.0f + __builtin_amdgcn_exp2f(-fabsf(z1[j]) * LOG2E)); }
                    *(f32x4*)(LF + (size_t)row * 8) = o0; *(f32x4*)(LF + (size_t)row * 8 + 4) = o1; }
        }
    }
};
struct EpiGate {
    static constexpr bool PERM = true, FUSE = false;
    bf16_t* G; const float* rss;
    __device__ __forceinline__ void operator()(AccRef acc, const Unit& u, int wr, int wc, int fr, int fq) const {
        const int row0 = u.pm * BM + wr * 64 + fr, col0 = u.pn * BM + wc * 32 + 8 * fq;
#pragma unroll
        for (int ai = 0; ai < 2; ++ai)
#pragma unroll
            for (int m = 0; m < 4; ++m) { const int row = row0 + ai * HALF + m * 16; const float rs = rstd_of(rss, row); bf16_t* rowp = G + (size_t)row * 3072 + col0;
#pragma unroll
                for (int bj = 0; bj < 2; ++bj) { const f32x4 v0 = acc[ai][bj][m][0] * rs, v1 = acc[ai][bj][m][1] * rs; u32x4 w;
                    w.x = cvt_pk_bf16(sigmoidf_(v0[0]), sigmoidf_(v0[1])); w.y = cvt_pk_bf16(sigmoidf_(v0[2]), sigmoidf_(v0[3]));
                    w.z = cvt_pk_bf16(sigmoidf_(v1[0]), sigmoidf_(v1[1])); w.w = cvt_pk_bf16(sigmoidf_(v1[2]), sigmoidf_(v1[3]));
                    *(u32x4*)(rowp + bj * HALF) = w; } }
    }
};
struct EpiBranch {
    static constexpr bool PERM = true, FUSE = false;
    const bf16_t* G; bf16_t* Mg;
    __device__ __forceinline__ void operator()(AccRef acc, const Unit& u, int wr, int wc, int fr, int fq) const {
        const int br = u.pn >> 2, ct = u.pn & 3;
        const int row0 = u.pm * BM + wr * 64 + fr, col0 = ct * BM + wc * 32 + 8 * fq;
#pragma unroll
        for (int ai = 0; ai < 2; ++ai) {
            u32x4 gwv[4][2], owv[4][2];
#pragma unroll
            for (int m = 0; m < 4; ++m) { const int row = row0 + ai * HALF + m * 16;
                const bf16_t* gp = G + (size_t)row * 3072 + br * 1024 + col0; const bf16_t* mp = Mg + (size_t)row * 1024 + col0;
#pragma unroll
                for (int bj = 0; bj < 2; ++bj) { gwv[m][bj] = *(const u32x4*)(gp + bj * HALF); if (br > 0) owv[m][bj] = *(const u32x4*)(mp + bj * HALF); } }
#pragma unroll
            for (int m = 0; m < 4; ++m) { const int row = row0 + ai * HALF + m * 16; bf16_t* mp = Mg + (size_t)row * 1024 + col0;
#pragma unroll
                for (int bj = 0; bj < 2; ++bj) {
                    const u32x4 gw = gwv[m][bj];
                    f32x4 v0 = acc[ai][bj][m][0], v1 = acc[ai][bj][m][1];
                    v0[0] *= bflo(gw.x); v0[1] *= bfhi(gw.x); v0[2] *= bflo(gw.y); v0[3] *= bfhi(gw.y);
                    v1[0] *= bflo(gw.z); v1[1] *= bfhi(gw.z); v1[2] *= bflo(gw.w); v1[3] *= bfhi(gw.w);
                    if (br > 0) { const u32x4 ow = owv[m][bj];
                        v0[0] += bflo(ow.x); v0[1] += bfhi(ow.x); v0[2] += bflo(ow.y); v0[3] += bfhi(ow.y);
                        v1[0] += bflo(ow.z); v1[1] += bfhi(ow.z); v1[2] += bflo(ow.w); v1[3] += bfhi(ow.w); }
                    u32x4 w; w.x = cvt_pk_bf16(v0[0], v0[1]); w.y = cvt_pk_bf16(v0[2], v0[3]); w.z = cvt_pk_bf16(v1[0], v1[1]); w.w = cvt_pk_bf16(v1[2], v1[3]);
                    *(u32x4*)(mp + bj * HALF) = w; } } }
    }
};
struct EpiBranch3 {
    static constexpr bool PERM = true, FUSE = true;
    const bf16_t* G; bf16_t* Mg;
    __device__ __forceinline__ bool fused(f32x4 (&acc)[2][2][4][2], const Unit& u, int wr, int wc, int fr, int fq) const {
        const int br = u.pn >> 2, ct = u.pn & 3;
        const int row0 = u.pm * BM + wr * 64 + fr, col0 = ct * BM + wc * 32 + 8 * fq;
#pragma unroll
        for (int ai = 0; ai < 2; ++ai) {
            u32x4 gav[4][2], gbv[4][2];
#pragma unroll
            for (int m = 0; m < 4; ++m) { const bf16_t* gp = G + (size_t)(row0 + ai * HALF + m * 16) * 3072 + br * 1024 + col0;
#pragma unroll
                for (int bj = 0; bj < 2; ++bj) { gav[m][bj] = *(const u32x4*)(gp + bj * HALF); if (br < 2) gbv[m][bj] = *(const u32x4*)(gp + 1024 + bj * HALF); } }
#pragma unroll
            for (int m = 0; m < 4; ++m) { bf16_t* mp = Mg + (size_t)(row0 + ai * HALF + m * 16) * 1024 + col0;
#pragma unroll
                for (int bj = 0; bj < 2; ++bj) {
                    const u32x4 ga = gav[m][bj]; float s[8];
                    s[0] = bflo(ga.x); s[1] = bfhi(ga.x); s[2] = bflo(ga.y); s[3] = bfhi(ga.y); s[4] = bflo(ga.z); s[5] = bfhi(ga.z); s[6] = bflo(ga.w); s[7] = bfhi(ga.w);
#pragma unroll
                    for (int j = 0; j < 8; ++j) s[j] = fmaxf(s[j], 1e-18f);
                    if (br < 2) { const u32x4 gb = gbv[m][bj]; float d[8];
                        d[0] = bflo(gb.x); d[1] = bfhi(gb.x); d[2] = bflo(gb.y); d[3] = bfhi(gb.y); d[4] = bflo(gb.z); d[5] = bfhi(gb.z); d[6] = bflo(gb.w); d[7] = bfhi(gb.w);
#pragma unroll
                        for (int j = 0; j < 8; ++j) s[j] *= __builtin_amdgcn_rcpf(fmaxf(d[j], 1e-18f)); }
                    f32x4 v0 = acc[ai][bj][m][0], v1 = acc[ai][bj][m][1];
                    v0[0] *= s[0]; v0[1] *= s[1]; v0[2] *= s[2]; v0[3] *= s[3]; v1[0] *= s[4]; v1[1] *= s[5]; v1[2] *= s[6]; v1[3] *= s[7];
                    if (br < 2) { acc[ai][bj][m][0] = v0; acc[ai][bj][m][1] = v1; }
                    else { u32x4 w; w.x = cvt_pk_bf16(v0[0], v0[1]); w.y = cvt_pk_bf16(v0[2], v0[3]); w.z = cvt_pk_bf16(v1[0], v1[1]); w.w = cvt_pk_bf16(v1[2], v1[3]);
                        *(u32x4*)(mp + bj * HALF) = w; } } } }
        return br == 2;
    }
};
struct EpiResid {
    static constexpr bool PERM = true, FUSE = false;
    const float* xin32; bf16_t* XB; unsigned* rssn;
    __device__ __forceinline__ void operator()(AccRef acc, const Unit& u, int wr, int wc, int fr, int fq) const {
        const int row0 = u.pm * BM + wr * 64 + fr, col0 = u.pn * BM + wc * 32 + 8 * fq;
#pragma unroll
        for (int ai = 0; ai < 2; ++ai) {
            f32x4 xv[4][2][2];
#pragma unroll
            for (int m = 0; m < 4; ++m) { const size_t off = (size_t)(row0 + ai * HALF + m * 16) * 1024 + col0;
#pragma unroll
                for (int bj = 0; bj < 2; ++bj) { const size_t o2 = off + bj * HALF;
                    if (xin32) { xv[m][bj][0] = *(const f32x4*)(xin32 + o2); xv[m][bj][1] = *(const f32x4*)(xin32 + o2 + 4); }
                    else { const u32x4 xw = *(const u32x4*)(XB + o2); xv[m][bj][0] = (f32x4){bflo(xw.x), bfhi(xw.x), bflo(xw.y), bfhi(xw.y)}; xv[m][bj][1] = (f32x4){bflo(xw.z), bfhi(xw.z), bflo(xw.w), bfhi(xw.w)}; } } }
#pragma unroll
            for (int m = 0; m < 4; ++m) { const int row = row0 + ai * HALF + m * 16; const size_t off = (size_t)row * 1024 + col0; float ss = 0.f;
#pragma unroll
                for (int bj = 0; bj < 2; ++bj) { const size_t o2 = off + bj * HALF;
                    const f32x4 x0 = xv[m][bj][0] + acc[ai][bj][m][0], x1 = xv[m][bj][1] + acc[ai][bj][m][1];
                    u32x4 w; w.x = cvt_pk_bf16(x0[0], x0[1]); w.y = cvt_pk_bf16(x0[2], x0[3]); w.z = cvt_pk_bf16(x1[0], x1[1]); w.w = cvt_pk_bf16(x1[2], x1[3]);
                    *(u32x4*)(XB + o2) = w;
                    ss += ((x0[0] * x0[0] + x0[1] * x0[1]) + (x0[2] * x0[2] + x0[3] * x0[3])) + ((x1[0] * x1[0] + x1[1] * x1[1]) + (x1[2] * x1[2] + x1[3] * x1[3])); }
                ss += __shfl_xor(ss, 16); ss += __shfl_xor(ss, 32);
                if (fq == 0) atomicAdd(rssn + row, (unsigned)(fminf(ss, 4.0e6f) * 256.0f + 0.5f)); } }
    }
};
struct EpiSwiglu {
    static constexpr bool PERM = true, FUSE = false;
    bf16_t* H; const float* rss;
    __device__ __forceinline__ void operator()(AccRef acc, const Unit& u, int wr, int wc, int fr, int fq) const {
        const int row0 = u.pm * BM + wr * 64 + fr, col0 = u.pn * 128 + wc * 32 + 8 * fq;
#pragma unroll
        for (int ai = 0; ai < 2; ++ai)
#pragma unroll
            for (int m = 0; m < 4; ++m) { const int row = row0 + ai * HALF + m * 16; const float rs = rstd_of(rss, row);
                float hv[8];
#pragma unroll
                for (int n = 0; n < 2; ++n)
#pragma unroll
                    for (int j = 0; j < 4; ++j) { const float gt = acc[ai][0][m][n][j] * rs, up = acc[ai][1][m][n][j] * rs; hv[n * 4 + j] = gt * sigmoidf_(gt) * up; }
                u32x4 w; w.x = cvt_pk_bf16(hv[0], hv[1]); w.y = cvt_pk_bf16(hv[2], hv[3]); w.z = cvt_pk_bf16(hv[4], hv[5]); w.w = cvt_pk_bf16(hv[6], hv[7]);
                *(u32x4*)(H + (size_t)row * DFF + col0) = w; }
    }
};
}

namespace att {
constexpr int SLOT = 33792;
constexpr int NSLOT = 4, OFF_TAB = NSLOT * SLOT, TAB_BYTES = 8704, OFF_UNIT = OFF_TAB + TAB_BYTES, OFF_VOTE = OFF_UNIT + 64, LDS_BYTES = OFF_VOTE + 128;
typedef LAS const char* lds_cptr;
typedef short v4i16_t __attribute__((ext_vector_type(4)));

DI void glds16(const void* gsrc, unsigned lds_dst) { unsigned keep;
    asm volatile("s_mov_b32 %0, m0\n\ts_mov_b32 m0, %2\n\ts_nop 0\n\tglobal_load_lds_dwordx4 %1, off\n\ts_mov_b32 m0, %0" : "=&s"(keep) : "v"(gsrc), "s"(lds_dst) : "memory"); }
DI unsigned cvtpk(float lo, float hi) { f32x2_t v = {lo, hi}; bf16x2_t b = __builtin_convertvector(v, bf16x2_t); return __builtin_bit_cast(unsigned, b); }
DI s16x4 vtr(lds_cptr p) { return __builtin_bit_cast(s16x4, __builtin_amdgcn_ds_read_tr16_b64_v4i16((LAS v4i16_t*)p)); }
DI float max3f(float a, float b, float c) { float r; asm("v_max3_f32 %0, %1, %2, %3" : "=v"(r) : "v"(a), "v"(b), "v"(c)); return r; }
DI float swapmax(float m) { auto rr = __builtin_amdgcn_permlane32_swap(__float_as_uint(m), __float_as_uint(m), false, false); return fmaxf(__uint_as_float(rr[0]), __uint_as_float(rr[1])); }
DI float swapsum(float m) { auto rr = __builtin_amdgcn_permlane32_swap(__float_as_uint(m), __float_as_uint(m), false, false); return __uint_as_float(rr[0]) + __uint_as_float(rr[1]); }
DI void store_pair16(bf16_t* p_even, int hi, u32x2 a, u32x2 b, bool dry) {
    auto rx = __builtin_amdgcn_permlane32_swap(a.x, b.x, false, false); auto ry = __builtin_amdgcn_permlane32_swap(a.y, b.y, false, false);
    const u32x4 w = (u32x4){(unsigned)rx[0], (unsigned)ry[0], (unsigned)rx[1], (unsigned)ry[1]};
    if (!dry) *(u32x4*)(p_even + 8 * hi) = w;
}
#define ATT_WAIT_BAR() asm volatile("s_waitcnt vmcnt(0) lgkmcnt(0)\n\ts_barrier" ::: "memory")
#define ATT_WAIT_BAR_N(N) asm volatile("s_waitcnt vmcnt(" #N ") lgkmcnt(0)\n\ts_barrier" ::: "memory")

struct Params {
    bf16_t* Qp; const bf16_t* Kp; const bf16_t* Vp; const float* CK; const bf16_t* KX;
    const float* t5; const float* relb; const float* dlam; const float* subg; float lam_init;
    unsigned* counter; const unsigned* order; const unsigned* nrm;
};

template <int KIND> DI void attn_unit(const Params& P, int b, int h, int qb, char* shm, float lam, bool dry = false) {
    constexpr int NDB = (KIND == 0) ? 4 : 2;
    const int tid = opaque_tid(), lane = tid & 63, r32 = lane & 31, hi = lane >> 5; const int wid = __builtin_amdgcn_readfirstlane(tid >> 6);
    const long rowbase = (long)b * SEQ;
    int qrow0, qoff, T_lo, T_hi, wt_lo, wt_hi; const int m = wid >> 2;
    if (KIND == 0) { qrow0 = qb * 128 + 32 * (wid & 3); qoff = h * 128 + m * 64; T_lo = 0; T_hi = 2 * qb + 1; wt_lo = 0; wt_hi = 2 * qb + ((wid & 3) >> 1); }
    else if (KIND == 1) { qrow0 = qb * 256 + 32 * wid; qoff = 512 + h * 64; const int cq = 4 * qb + (wid >> 1); T_lo = 4 * qb - 8 < 0 ? 0 : 4 * qb - 8; T_hi = 4 * qb + 3; wt_lo = cq - 8 < 0 ? 0 : cq - 8; wt_hi = cq; }
    else { qrow0 = qb * 256 + 32 * wid; qoff = 1024 + h * 64; T_lo = 0; T_hi = 4 * qb + 3; wt_lo = 0; wt_hi = 4 * qb + (wid >> 1); }
    const int kvoff = (KIND == 0) ? h * 128 : qoff;
    const unsigned lds0 = (unsigned)(uintptr_t)shm;
    const lds_cptr shm3 = (lds_cptr)shm;
    const int hk = kvoff >> 6, vb0 = kvoff >> 5;
    const bf16_t* ksrc = P.Kp + ((size_t)(b * 24 + hk) * 256) * 4096 + wid * 512 + lane * 8;
    const bf16_t* vsrc0 = P.Vp + ((size_t)(b * 48 + vb0 + (wid >> 2)) * 256) * 2048 + (wid & 3) * 512 + lane * 8;
    const bf16_t* kxsrc = P.KX + ((size_t)(b * 8 + h) * SEQ + lane) * 8;
#define ATT_DMA(t, so) do { const unsigned sb_ = lds0 + (so); \
        glds16(ksrc + (size_t)(t) * 4096, (unsigned)__builtin_amdgcn_readfirstlane(sb_ + wid * 1024)); \
        if (KIND == 0) glds16(ksrc + (size_t)(t) * 4096 + (size_t)256 * 4096, (unsigned)__builtin_amdgcn_readfirstlane(sb_ + 8192 + wid * 1024)); \
        glds16(vsrc0 + (size_t)(t) * 2048, (unsigned)__builtin_amdgcn_readfirstlane(sb_ + 16384 + wid * 1024)); \
        if (KIND == 0) glds16(vsrc0 + (size_t)(t) * 2048 + (size_t)2 * 256 * 2048, (unsigned)__builtin_amdgcn_readfirstlane(sb_ + 16384 + 8192 + wid * 1024)); \
        if (KIND == 2 && wid == 0) glds16(kxsrc + (size_t)(t) * 64 * 8, (unsigned)__builtin_amdgcn_readfirstlane(sb_ + 32768)); } while (0)
    float cb = 0.f;
    if (KIND == 0) { cb = P.t5[15 * 4 + h] * LOG2E;
        for (int i = tid; i < 2175; i += 512) { const int rel = i - 2111; const int n = rel < 0 ? -rel : rel;
            int lg = 36 - __builtin_clz((unsigned)(n | 1)); lg = lg > 15 ? 15 : lg; int idx = n < 8 ? n : lg; idx += rel > 0 ? 16 : 0;
            *(LAS float*)(shm3 + OFF_TAB + i * 4) = P.t5[idx * 4 + h] * LOG2E - cb; } }
    if (KIND == 1) { cb = P.relb[h] * LOG2E;
        if (tid < 255) { int idx = tid - 191; idx = idx < -128 ? -128 : idx; *(LAS float*)(shm3 + OFF_TAB + tid * 4) = P.relb[(idx + 128) * 8 + h] * LOG2E - cb; } }
    const int NT = T_hi - T_lo + 1;
#define ATT_TILE(i) ((KIND == 2) ? T_hi - (i) : T_lo + (i))
    ATT_DMA(ATT_TILE(0), 0);
    if (NT > 1) ATT_DMA(ATT_TILE(1), SLOT);
    if (NT > 2) ATT_DMA(ATT_TILE(2), 2 * SLOT);
    bf16x8 qr[4];
    { const bf16_t* qp = P.Qp + (rowbase + qrow0 + r32) * PITCH + qoff + hi * 8;
#pragma unroll
      for (int d0 = 0; d0 < 4; ++d0) qr[d0] = *(const bf16x8*)(qp + d0 * 16); }
    float qkmax = 0.f;
    if (KIND == 2) { cb = P.CK[(size_t)(b * 8 + h) * SEQ + qrow0 + r32]; const unsigned* np = P.nrm + (b * 8 + h) * 4; qkmax = (sqrtf(__uint_as_float(np[0]) * __uint_as_float(np[2])) + sqrtf(__uint_as_float(np[1]) * __uint_as_float(np[3]))) * 1.001f + 0.01f; }
    asm volatile("" : "+v"(qr[0]), "+v"(qr[1]), "+v"(qr[2]), "+v"(qr[3]), "+v"(cb), "+v"(qkmax));
    bf16x8 ones = (bf16x8){0, 0, 0, 0, 0, 0, 0, 0}; if (KIND == 2 && hi == 0) { ones[0] = 0x3F80; ones[1] = 0x3F80; ones[2] = 0x3F80; }
    float mhat = 0.f, lsum = 0.f; f32x16 o[NDB]; f32x16 negm;
#pragma unroll
    for (int i = 0; i < NDB; ++i) o[i] = f32x16{};
#pragma unroll
    for (int r = 0; r < 16; ++r) negm[r] = cb;
    const int vlane = ((lane >> 4) & 1) * 32 + (lane & 3) * 8 + (4 * hi + ((lane & 15) >> 2)) * 64;
    LAS unsigned* vote = (LAS unsigned*)(shm3 + OFF_VOTE);
    if (KIND == 2 && tid < 32) vote[tid] = 0u;
    ATT_WAIT_BAR();
    int sc = 0, sd = 3 * SLOT;
    int nt_eff = NT;
#define SBAR() __builtin_amdgcn_sched_barrier(0)
#define PIN(x) asm volatile("" : "+v"(x))
#define MF(a_, b_, c_) __builtin_amdgcn_mfma_f32_32x32x16_bf16(a_, b_, c_, 0, 0, 0)
#define EX(v) __builtin_amdgcn_exp2f(v)
#define ATT_KLD(so_, h_) do { const lds_cptr kb_ = shm3 + (so_) + ((KIND == 0) ? m * 8192 : 0) + hi * 1024 + r32 * 16 + (h_) * 4096; \
        kf[0] = *(const LAS bf16x8*)(kb_); kf[1] = *(const LAS bf16x8*)(kb_ + 512); kf[2] = *(const LAS bf16x8*)(kb_ + 2048); kf[3] = *(const LAS bf16x8*)(kb_ + 2560); } while (0)
#define ATT_XLD(so_) do { if (KIND == 2) { const lds_cptr xb_ = shm3 + (so_) + 32768 + r32 * 16; x0 = *(const LAS bf16x8*)(xb_); x1 = *(const LAS bf16x8*)(xb_ + 512); if (hi) { x0 = (bf16x8){0, 0, 0, 0, 0, 0, 0, 0}; x1 = x0; } } } while (0)
#define ATT_FIX(P0, P1, t_) do { const int tt_ = (t_); \
        if (KIND == 0 && (tt_ * 64 + 63 - qrow0) > -2048) { const lds_cptr tp = shm3 + OFF_TAB + (tt_ * 64 - qrow0 - r32 + 4 * hi + 2111) * 4; \
            _Pragma("unroll") for (int r = 0; r < 16; ++r) { P0[r] += *(LAS const float*)(tp + 4 * ((r & 3) + 8 * (r >> 2))); P1[r] += *(LAS const float*)(tp + 4 * ((r & 3) + 8 * (r >> 2) + 32)); } } \
        if (KIND == 1 && tt_ >= (qrow0 >> 6) - 2) { const lds_cptr tp = shm3 + OFF_TAB + (tt_ * 64 - qrow0 - r32 + 4 * hi + 191) * 4; \
            _Pragma("unroll") for (int r = 0; r < 16; ++r) { P0[r] += *(LAS const float*)(tp + 4 * ((r & 3) + 8 * (r >> 2))); P1[r] += *(LAS const float*)(tp + 4 * ((r & 3) + 8 * (r >> 2) + 32)); } } \
        if (KIND == 2 && tt_ == wt_hi) { const int ql = (qrow0 & 63) + r32; \
            _Pragma("unroll") for (int r = 0; r < 16; ++r) { const int kv = (r & 3) + 8 * (r >> 2) + 4 * hi; if (kv > ql) P0[r] = -INFINITY; if (kv + 32 > ql) P1[r] = -INFINITY; } } \
        if (tt_ < wt_lo || tt_ > wt_hi) { _Pragma("unroll") for (int r = 0; r < 16; ++r) { P0[r] = -INFINITY; P1[r] = -INFINITY; } } } while (0)
#define ATT_DECIDE(P0, P1, rm_) do { if (__any((rm_) > 6.0f)) { const float dl = fmaxf((rm_), 0.f); mhat += dl; const float f = EX(-dl); lsum *= f; \
            _Pragma("unroll") for (int r = 0; r < 16; ++r) { P0[r] -= dl; P1[r] -= dl; negm[r] -= dl; } \
            _Pragma("unroll") for (int i2 = 0; i2 < NDB; ++i2) _Pragma("unroll") for (int r = 0; r < 16; ++r) o[i2][r] *= f; } } while (0)
#define ATT_STEP_BAR(i) do { if ((i) >= 1 && (i) + 2 < NT) { if (KIND == 0) ATT_WAIT_BAR_N(4); else if (KIND == 2 && wid == 0) ATT_WAIT_BAR_N(3); else ATT_WAIT_BAR_N(2); } else ATT_WAIT_BAR(); \
        if ((i) + 3 < NT) ATT_DMA(ATT_TILE((i) + 3), sd); \
        if (KIND == 2 && (i) >= 1) { const u32x4 v0 = *(const LAS u32x4*)(vote + 8 * (((i) - 1) & 3)), v1 = *(const LAS u32x4*)(vote + 8 * (((i) - 1) & 3) + 4); \
            if ((v0.x & v0.y & v0.z & v0.w & v1.x & v1.y & v1.z & v1.w) != 0u && (i) + 1 < nt_eff) nt_eff = (i) + 1; } } while (0)
    f32x16 pa0, pa1, pb0, pb1;
    bf16x8 kf[4], x0, x1;
    ATT_KLD(0, 0); ATT_XLD(0);
    pa0 = MF(kf[0], qr[0], negm); pa1 = MF(kf[1], qr[0], negm); pa0 = MF(kf[2], qr[1], pa0); pa1 = MF(kf[3], qr[1], pa1);
    SBAR(); ATT_KLD(0, 1); SBAR();
    pa0 = MF(kf[0], qr[2], pa0); pa1 = MF(kf[1], qr[2], pa1); pa0 = MF(kf[2], qr[3], pa0); pa1 = MF(kf[3], qr[3], pa1);
    if (KIND == 2) { pa0 = MF(x0, ones, pa0); pa1 = MF(x1, ones, pa1); }
    ATT_FIX(pa0, pa1, ATT_TILE(0));
    { float rm = max3f(pa0[0], pa0[1], pa1[0]), rm2 = max3f(pa0[2], pa0[3], pa1[1]); rm = max3f(rm, pa1[2], pa1[3]);
#pragma unroll
      for (int r = 4; r < 16; r += 4) { rm = max3f(rm, pa0[r], pa0[r + 1]); rm2 = max3f(rm2, pa0[r + 2], pa0[r + 3]); rm = max3f(rm, pa1[r], pa1[r + 1]); rm2 = max3f(rm2, pa1[r + 2], pa1[r + 3]); }
      rm = swapmax(max3f(rm, rm2, rm2)); ATT_DECIDE(pa0, pa1, rm); }
    for (int i = 0; i < nt_eff; ++i) {
        ATT_STEP_BAR(i);
        const int sn = (sc == 3 * SLOT) ? 0 : sc + SLOT;
        const lds_cptr vp = shm3 + sc + 16384 + vlane;
        bf16x8 vq[4]; bf16x8 pw[4]; u32x4 w0, w1; float sacc = 0.f;
#define LDV(j_) do { if ((j_) < 4 * NDB) { const lds_cptr a_ = vp + ((j_) % NDB) * 4096 + ((j_) / NDB) * 1024; const s16x4 lo_ = vtr(a_), hi_ = vtr(a_ + 512); \
            vq[(j_) & 3] = (bf16x8){lo_[0], lo_[1], lo_[2], lo_[3], hi_[0], hi_[1], hi_[2], hi_[3]}; } } while (0)
#define PVM(j_) o[(j_) % NDB] = MF(vq[(j_) & 3], pw[(j_) / NDB], o[(j_) % NDB])
        ATT_KLD(sn, 0); ATT_XLD(sn);
        SBAR();
#define G1(MFMA_, a_, W_, j_) do { MFMA_; pa0[a_] = EX(pa0[a_]); pa0[a_ + 1] = EX(pa0[a_ + 1]); sacc += pa0[a_]; sacc += pa0[a_ + 1]; W_[j_] = cvtpk(pa0[a_], pa0[a_ + 1]); PIN(pa0); PIN(sacc); PIN(W_); SBAR(); } while (0)
        G1(pb0 = MF(kf[0], qr[0], negm), 0, w0, 0);  G1(pb1 = MF(kf[1], qr[0], negm), 2, w0, 1);
        G1(pb0 = MF(kf[2], qr[1], pb0), 4, w0, 2);   G1(pb1 = MF(kf[3], qr[1], pb1), 6, w0, 3);
        ATT_KLD(sn, 1);
        SBAR();
        G1(pb0 = MF(kf[0], qr[2], pb0), 8, w1, 0);   G1(pb1 = MF(kf[1], qr[2], pb1), 10, w1, 1);
        LDV(0); SBAR();
        G1(pb0 = MF(kf[2], qr[3], pb0), 12, w1, 2);
        LDV(1); SBAR();
        G1(pb1 = MF(kf[3], qr[3], pb1), 14, w1, 3);
        LDV(2); SBAR();
#undef G1
        if (KIND == 2) { pb0 = MF(x0, ones, pb0); pb1 = MF(x1, ones, pb1); }
        pw[0] = __builtin_bit_cast(bf16x8, w0); pw[1] = __builtin_bit_cast(bf16x8, w1);
#define E4(a_, W_, j_) do { pa1[a_] = EX(pa1[a_]); pa1[a_ + 1] = EX(pa1[a_ + 1]); sacc += pa1[a_]; sacc += pa1[a_ + 1]; W_[j_] = cvtpk(pa1[a_], pa1[a_ + 1]); } while (0)
        if (NDB == 4) {
            LDV(3); PVM(0); E4(0, w0, 0); PIN(pa1); PIN(sacc); PIN(w0); SBAR();
            LDV(4); PVM(1); E4(2, w0, 1); PIN(pa1); PIN(sacc); PIN(w0); SBAR();
            LDV(5); PVM(2); E4(4, w0, 2); PIN(pa1); PIN(sacc); PIN(w0); SBAR();
            LDV(6); PVM(3); E4(6, w0, 3); PIN(pa1); PIN(sacc); PIN(w0); SBAR();
            LDV(7); PVM(4); E4(8, w1, 0); PIN(pa1); PIN(sacc); PIN(w1); SBAR();
            LDV(8); PVM(5); E4(10, w1, 1); PIN(pa1); PIN(sacc); PIN(w1); SBAR();
            LDV(9); PVM(6); E4(12, w1, 2); PIN(pa1); PIN(sacc); PIN(w1); SBAR();
            LDV(10); PVM(7); E4(14, w1, 3); PIN(pa1); PIN(sacc); PIN(w1); SBAR();
        } else {
            LDV(3); PVM(0); E4(0, w0, 0); E4(2, w0, 1); PIN(pa1); PIN(sacc); PIN(w0); SBAR();
            LDV(4); PVM(1); E4(4, w0, 2); E4(6, w0, 3); PIN(pa1); PIN(sacc); PIN(w0); SBAR();
            LDV(5); PVM(2); E4(8, w1, 0); E4(10, w1, 1); PIN(pa1); PIN(sacc); PIN(w1); SBAR();
            LDV(6); PVM(3); E4(12, w1, 2); E4(14, w1, 3); PIN(pa1); PIN(sacc); PIN(w1); SBAR();
        }
#undef E4
        pw[2] = __builtin_bit_cast(bf16x8, w0); pw[3] = __builtin_bit_cast(bf16x8, w1);
        lsum += sacc;
        ATT_FIX(pb0, pb1, ATT_TILE(i + 1));
        float rm, rm2;
        if (NDB == 4) {
            LDV(11); PVM(8); rm = max3f(pb0[0], pb0[1], pb1[0]); rm2 = max3f(pb0[2], pb0[3], pb1[1]); PIN(rm); PIN(rm2); SBAR();
            LDV(12); PVM(9); rm = max3f(rm, pb1[2], pb1[3]); rm2 = max3f(rm2, pb0[4], pb0[5]); PIN(rm); PIN(rm2); SBAR();
            LDV(13); PVM(10); rm = max3f(rm, pb0[6], pb0[7]); rm2 = max3f(rm2, pb1[4], pb1[5]); PIN(rm); PIN(rm2); SBAR();
            LDV(14); PVM(11); rm = max3f(rm, pb1[6], pb1[7]); rm2 = max3f(rm2, pb0[8], pb0[9]); PIN(rm); PIN(rm2); SBAR();
            LDV(15); PVM(12); rm = max3f(rm, pb0[10], pb0[11]); rm2 = max3f(rm2, pb1[8], pb1[9]); PIN(rm); PIN(rm2); SBAR();
            PVM(13); rm = max3f(rm, pb1[10], pb1[11]); rm2 = max3f(rm2, pb0[12], pb0[13]); PIN(rm); PIN(rm2); SBAR();
            PVM(14); rm = max3f(rm, pb0[14], pb0[15]); rm2 = max3f(rm2, pb1[12], pb1[13]); PIN(rm); PIN(rm2); SBAR();
            PVM(15); rm = max3f(rm, pb1[14], pb1[15]); PIN(rm); SBAR();
        } else {
            LDV(7); PVM(4); rm = max3f(pb0[0], pb0[1], pb1[0]); rm2 = max3f(pb0[2], pb0[3], pb1[1]); rm = max3f(rm, pb1[2], pb1[3]); rm2 = max3f(rm2, pb0[4], pb0[5]); PIN(rm); PIN(rm2); SBAR();
            PVM(5); rm = max3f(rm, pb0[6], pb0[7]); rm2 = max3f(rm2, pb1[4], pb1[5]); rm = max3f(rm, pb1[6], pb1[7]); rm2 = max3f(rm2, pb0[8], pb0[9]); PIN(rm); PIN(rm2); SBAR();
            PVM(6); rm = max3f(rm, pb0[10], pb0[11]); rm2 = max3f(rm2, pb1[8], pb1[9]); rm = max3f(rm, pb1[10], pb1[11]); rm2 = max3f(rm2, pb0[12], pb0[13]); PIN(rm); PIN(rm2); SBAR();
            PVM(7); rm = max3f(rm, pb0[14], pb0[15]); rm2 = max3f(rm2, pb1[12], pb1[13]); rm = max3f(rm, pb1[14], pb1[15]); PIN(rm); PIN(rm2); SBAR();
        }
#undef LDV
#undef PVM
        rm = swapmax(max3f(rm, rm2, rm2));
        if (KIND == 2) {
            const u32x2 kx = *(const LAS u32x2*)(shm3 + sc + 32768);
            const float xk0 = __uint_as_float(kx.x << 16) + __uint_as_float(kx.x & 0xffff0000u) + __uint_as_float(kx.y << 16);
            const float ltot = swapsum(lsum);
            const bool ok = (qkmax + cb + xk0) < (mhat + __builtin_amdgcn_logf(ltot) - 54.0f);
            const bool allok = __all(ok) && !(ATT_TILE(i) > wt_hi);
            if (lane == 0) vote[8 * (i & 3) + wid] = allok ? 1u : 0u;
        }
        if (i + 1 < nt_eff) ATT_DECIDE(pb0, pb1, rm);
        pa0 = pb0; pa1 = pb1;
        sc = sn; sd = (sd == 3 * SLOT) ? 0 : sd + SLOT;
    }
#undef ATT_STEP_BAR
#undef ATT_TILE
#undef ATT_KLD
#undef ATT_XLD
#undef ATT_FIX
#undef ATT_DECIDE
#undef SBAR
#undef PIN
#undef MF
#undef EX
    const float rl = __builtin_amdgcn_rcpf(swapsum(lsum));
    bf16_t* orow = P.Qp + (rowbase + qrow0 + r32) * PITCH + ((KIND == 0) ? h * 128 : qoff);
    ATT_WAIT_BAR();
    if (KIND == 0) {
        LAS float* comb = (LAS float*)shm3 + (size_t)(wid & 3) * 4096 + lane;
        if (m == 1) {
#pragma unroll
            for (int db = 0; db < NDB; ++db)
#pragma unroll
                for (int r = 0; r < 16; ++r) comb[(db * 16 + r) * 64] = o[db][r] * rl;
        }
        ATT_WAIT_BAR();
        if (m == 0) {
            float ss = 0.f;
#pragma unroll
            for (int db = 0; db < NDB; ++db)
#pragma unroll
                for (int r = 0; r < 16; ++r) { const float d = o[db][r] * rl - lam * comb[(db * 16 + r) * 64]; o[db][r] = d; ss += d * d; }
            ss = swapsum(ss);
            const float sc = __builtin_amdgcn_rsqf(ss * (1.0f / 128.0f) + RMS_EPS) * (1.0f - P.lam_init);
#pragma unroll
            for (int db = 0; db < NDB; ++db)
#pragma unroll
                for (int g = 0; g < 4; g += 2) { u32x2 wp[2];
#pragma unroll
                    for (int e = 0; e < 2; ++e) { const f32x4 sg = *(const f32x4*)(P.subg + db * 32 + 8 * (g + e) + 4 * hi); const int r = 4 * (g + e);
                        wp[e].x = cvtpk(o[db][r] * sc * sg[0], o[db][r + 1] * sc * sg[1]); wp[e].y = cvtpk(o[db][r + 2] * sc * sg[2], o[db][r + 3] * sc * sg[3]); }
                    store_pair16(orow + db * 32 + 8 * g, hi, wp[0], wp[1], dry); }
        }
        ATT_WAIT_BAR();
    } else {
#pragma unroll
        for (int db = 0; db < NDB; ++db)
#pragma unroll
            for (int g = 0; g < 4; g += 2) { u32x2 wp[2];
#pragma unroll
                for (int e = 0; e < 2; ++e) { const int r = 4 * (g + e); wp[e].x = cvtpk(o[db][r] * rl, o[db][r + 1] * rl); wp[e].y = cvtpk(o[db][r + 2] * rl, o[db][r + 3] * rl); }
                store_pair16(orow + db * 32 + 8 * g, hi, wp[0], wp[1], dry); }
    }
#undef ATT_DMA
}

DI void attn_phase(const Params& P, char* shm) {
    const int tid = opaque_tid(), lane = tid & 63;
    float lam;
    { const float a = P.dlam[lane] * P.dlam[64 + lane], c = P.dlam[128 + lane] * P.dlam[192 + lane]; float sa = a, sc = c;
#pragma unroll
      for (int o = 1; o < 64; o <<= 1) { sa += __shfl_xor(sa, o); sc += __shfl_xor(sc, o); }
      lam = __builtin_amdgcn_exp2f(sa * LOG2E) - __builtin_amdgcn_exp2f(sc * LOG2E) + P.lam_init; }
    LAS unsigned* su = (LAS unsigned*)((att::lds_cptr)shm + OFF_UNIT);
    if (tid >= 256) __builtin_amdgcn_s_setprio(1);
    const unsigned xcd = (unsigned)__builtin_amdgcn_s_getreg((3 << 11) | 20) & 7u;
    for (unsigned k = 0; k < 8; ++k) {
        const unsigned q = (xcd + k) & 7u; unsigned* cnt = P.counter + 16 * q;
        for (;;) {
            if (tid == 0) su[0] = atomicAdd(cnt, 1u);
            ATT_WAIT_BAR();
            const unsigned ui = su[0];
            ATT_WAIT_BAR();
            if (ui >= 384u) break;
            const unsigned e = P.order[q * 384 + ui]; const int kind = e >> 28, b = (e >> 24) & 15, h = (e >> 16) & 255, qb = e & 0xffff;
#if defined(PROBE_REP_A) || defined(PROBE_REP_C)
            { const int reps = (kind == 0) ? PROBE_REP_A : (kind == 2 ? PROBE_REP_C : 1);
              for (int rep = 1; rep < reps; ++rep) { if (kind == 0) attn_unit<0>(P, b, h, qb, shm, lam, P.lam_init > -1.0f); else attn_unit<2>(P, b, h, qb, shm, lam, P.lam_init > -1.0f); ATT_WAIT_BAR(); } }
#endif
            if (kind == 0) attn_unit<0>(P, b, h, qb, shm, lam);
            else if (kind == 1) attn_unit<1>(P, b, h, qb, shm, lam);
            else attn_unit<2>(P, b, h, qb, shm, lam);
            ATT_WAIT_BAR();
        }
    }
    __builtin_amdgcn_s_setprio(0);
}
}

#define XB_TMO      128
#define XB_XCNT(j)  (256  + 64 * (j))
#define XB_XSUB(j)  (1280 + 64 * (j))
#define XB_XGEN(j)  (2304 + 64 * (j))
#define XB_TOP      3328
#define XB_TOPGEN   3392
#define XCD_BAR_WORDS 3456
#define XB_SPIN_CAP (1u << 18)

__device__ __forceinline__ unsigned xb_ld(unsigned* p)              { return __hip_atomic_load(p, __ATOMIC_RELAXED, __HIP_MEMORY_SCOPE_AGENT); }
__device__ __forceinline__ unsigned xb_add(unsigned* p, unsigned v) { return __hip_atomic_fetch_add(p, v, __ATOMIC_RELAXED, __HIP_MEMORY_SCOPE_AGENT); }
__device__ __forceinline__ unsigned xb_xcc_id() { return (unsigned)__builtin_amdgcn_s_getreg((3 << 11) | 20) & 0xFu; }
#define XB_SPIN(cond, bar) do { unsigned _sp = 0; while (cond) { __builtin_amdgcn_s_sleep(1); \
    if ((++_sp & 255u) == 0u) { if (xb_ld(&(bar)[XB_TMO])) break; if (_sp > XB_SPIN_CAP) { atomicAdd(&(bar)[XB_TMO], 1u); break; } } } } while (0)

struct XcdBarrier {
    unsigned* bar; unsigned x;
    volatile LAS unsigned* st;
};

__device__ __forceinline__ XcdBarrier xcd_barrier_post(unsigned* bar, volatile LAS unsigned* st) {
    XcdBarrier b; b.bar = bar; b.x = xb_xcc_id(); b.st = st;
    if (threadIdx.x == 0) (void)xb_add(&bar[XB_XCNT(b.x)], 1u);
    return b;
}
__device__ __forceinline__ void xcd_barrier_complete(unsigned* bar, unsigned x, unsigned& nloc, unsigned& nx) {
    const unsigned G = gridDim.x * gridDim.y * gridDim.z;
    unsigned sum, cnt, mine, sp = 0u;
    for (;;) {
        sum = 0u; cnt = 0u; mine = 0u;
#pragma unroll
        for (unsigned j = 0; j < 16; ++j) { const unsigned c = xb_ld(&bar[XB_XCNT(j)]); sum += c; cnt += (c > 0u) ? 1u : 0u; mine = (j == x) ? c : mine; }
        if (sum == G) break;
        __builtin_amdgcn_s_sleep(1);
        if ((++sp & 255u) == 0u) { if (xb_ld(&bar[XB_TMO])) break; if (sp > XB_SPIN_CAP) { atomicAdd(&bar[XB_TMO], 1u); break; } }
    }
    nloc = mine > 0u ? mine : 1u; nx = cnt > 0u ? cnt : 1u;
}

__device__ __forceinline__ void xcd_barrier(const XcdBarrier& b) {
    asm volatile("s_waitcnt vmcnt(0)" ::: "memory");
    __syncthreads();
    if (threadIdx.x == 0) {
        unsigned* bar = b.bar;
        __builtin_amdgcn_s_waitcnt(0);
        unsigned nloc = b.st[0], nx = b.st[1];
        if (nloc == 0u) { xcd_barrier_complete(bar, b.x, nloc, nx); b.st[0] = nloc; b.st[1] = nx; }
        const unsigned old = xb_add(&bar[XB_XSUB(b.x)], 1u);
        const unsigned gen = old / nloc;
        if (old + 1u == (gen + 1u) * nloc) {
            __builtin_amdgcn_fence(__ATOMIC_RELEASE, "agent");
            asm volatile("s_waitcnt vmcnt(0)" ::: "memory");
            const unsigned og = xb_add(&bar[XB_TOP], 1u);
            const unsigned tg = og / nx;
            if (og + 1u == (tg + 1u) * nx) xb_add(&bar[XB_TOPGEN], 1u);
            else XB_SPIN(xb_ld(&bar[XB_TOPGEN]) == tg, bar);
            __builtin_amdgcn_fence(__ATOMIC_ACQUIRE, "agent");
            xb_add(&bar[XB_XGEN(b.x)], 1u);
            asm volatile("s_waitcnt vmcnt(0)" ::: "memory");
        } else {
            XB_SPIN(xb_ld(&bar[XB_XGEN(b.x)]) == gen, bar);
            __builtin_amdgcn_fence(__ATOMIC_ACQUIRE, "agent");
            asm volatile("s_waitcnt vmcnt(0)" ::: "memory");
        }
    }
    __syncthreads();
}

constexpr int NWAVES = 8;
constexpr int LDS_BYTES = 147456;

struct Args {
    const float* in[16]; float* out; unsigned char* ws; int ph_lo, ph_hi;
};
constexpr int N_PHASES = 18;

DI float wave_sum(float v) {
#pragma unroll
    for (int o = 1; o < 64; o <<= 1) v += __shfl_xor(v, o);
    return v;
}
DI unsigned f2bf(float f) { unsigned u = __builtin_bit_cast(unsigned, f); return (u + 0x7fffu + ((u >> 16) & 1u)) >> 16; }
DI unsigned pk2(float lo, float hi) { return f2bf(lo) | (f2bf(hi) << 16); }

DI void conv_item(const float* W, int ldw, int src_col0, int k0, const float* gv, bf16_t* WT, int ldt, int dst_row0, LAS float* scr, int lane) {
    { f32x4 wv[8]; float gs[8];
#pragma unroll
      for (int i = 0; i < 8; ++i) { const int kk = 8 * i + (lane >> 3); wv[i] = *(const f32x4*)(W + (size_t)(k0 + kk) * ldw + src_col0 + (lane & 7) * 4); gs[i] = gv ? gv[k0 + kk] : 1.0f; }
#pragma unroll
      for (int i = 0; i < 8; ++i) { const int kk = 8 * i + (lane >> 3); LAS float* d = scr + kk * 33 + (lane & 7) * 4; const f32x4 v = wv[i] * gs[i]; d[0] = v.x; d[1] = v.y; d[2] = v.z; d[3] = v.w; } }
    asm volatile("s_waitcnt lgkmcnt(0)" ::: "memory");
    const int c = lane & 7;
#pragma unroll
    for (int j = 0; j < 4; ++j) { const int n = (lane >> 3) + 8 * j; const LAS float* s = scr + (8 * c) * 33 + n;
        u32x4 o; o.x = pk2(s[0 * 33], s[1 * 33]); o.y = pk2(s[2 * 33], s[3 * 33]); o.z = pk2(s[4 * 33], s[5 * 33]); o.w = pk2(s[6 * 33], s[7 * 33]);
        *(u32x4*)(WT + (size_t)(dst_row0 + n) * ldt + k0 + 8 * c) = o; }
    asm volatile("s_waitcnt lgkmcnt(0)" ::: "memory");
}

DI void conv_weights(const Args& a, LAS unsigned char* lds, int l, int gw, int NGW, int wave, int lane) {
    unsigned char* ws = a.ws;
    LAS float* scr = (LAS float*)(lds + wave * 16384);
    constexpr int I_QKV = 9 * 256, I_CF = 256, I_G = 16 * 96, I_BR = 3 * 256, I_OUT = 512, I_GU = 16 * 176, I_DN = 44 * 32;
    constexpr int I_LAYER = I_QKV + I_CF + I_G + I_BR + I_OUT + I_GU + I_DN;
    for (int it = gw; it < I_LAYER; it += NGW) {
        int r = it;
        unsigned char* wl = ws + WS_W + (size_t)l * W_LAYER;
        const float* w_in = a.in[2] + (size_t)l * D * INW; const float* gmix = a.in[1] + l * D;
        if (r < I_QKV) { const int grp = r / 256, q = r % 256, kb = q / 16, nb = q % 16;
            const int srcs[9] = {0, 1536, 3072, 512, 2048, 3584, 1024, 2560, 4096};
            int sc = 0;
#pragma unroll
            for (int i = 0; i < 9; ++i) sc = (grp == i) ? srcs[i] : sc;
            conv_item(w_in, INW, sc + nb * 32, kb * 64, gmix, (bf16_t*)(wl + W_QKV), D, grp * 512 + nb * 32, scr, lane); continue; } r -= I_QKV;
        if (r < I_CF) { bf16_t* dst = (bf16_t*)(wl + W_QKV) + (size_t)(4608 + r) * D;
            for (int k = lane; k < D; k += 64) dst[k] = (r < 8) ? (bf16_t)f2bf(w_in[(size_t)k * INW + 4608 + r] * gmix[k]) : (bf16_t)0; continue; } r -= I_CF;
        if (r < I_G) { const int kb = r / 96, nb = r % 96; conv_item(w_in, INW, 4616 + nb * 32, kb * 64, gmix, (bf16_t*)(wl + W_G), D, nb * 32, scr, lane); continue; } r -= I_G;
        if (r < I_BR) { const int br = r / 256, q = r % 256, kb = q / 32, nb = q % 32; const float* w = a.in[8 + br] + (size_t)l * 512 * D;
            conv_item(w, D, nb * 32, kb * 64, nullptr, (bf16_t*)(wl + W_BR), 512, br * 1024 + nb * 32, scr, lane); continue; } r -= I_BR;
        if (r < I_OUT) { const int kb = r / 32, nb = r % 32; conv_item(a.in[11] + (size_t)l * D * D, D, nb * 32, kb * 64, nullptr, (bf16_t*)(wl + W_OUT), D, nb * 32, scr, lane); continue; } r -= I_OUT;
        if (r < I_GU) { const int kb = r / 176, nb = r % 176; const int n0 = nb * 32, pn = n0 >> 8, bj = (n0 >> 7) & 1, j = n0 & 127;
            conv_item(a.in[13] + (size_t)l * D * 2 * DFF, 2 * DFF, bj * DFF + 128 * pn + j, kb * 64, a.in[12] + l * D, (bf16_t*)(wl + W_GU), D, n0, scr, lane); continue; } r -= I_GU;
        { const int kb = r / 32, nb = r % 32; conv_item(a.in[14] + (size_t)l * DFF * D, D, nb * 32, kb * 64, nullptr, (bf16_t*)(wl + W_DN), DFF, nb * 32, scr, lane); }
    }
}

DI void prologue(const Args& a, LAS unsigned char* lds, int gw, int NGW, int wave, int lane) {
    unsigned char* ws = a.ws;
    if (blockIdx.x == 0 && wave == 0 && lane < 16) {
        const int l = lane >> 3, q = lane & 7; unsigned* tab = (unsigned*)(ws + WS_ORDER) + (l * 8 + q) * 384; int ia = 0, ic0 = 0, ic1 = 0, pos = 0;
        int nh[2];
#pragma unroll
        for (int j = 0; j < 2; ++j) { const float bfv = a.in[3][l * 8 + ((2 * q + j) & 7)]; const float rate = 64.0f * __builtin_amdgcn_logf(1.0f + __builtin_amdgcn_exp2f((0.5f - bfv) * LOG2E)); float n = 82.0f / rate + 6.0f; n = n > 300.f ? 300.f : n; nh[j] = (int)n; }
        while (ia < 128 || ic0 < 64 || ic1 < 64) {
            const int t0 = 4 * (64 - ic0), t1 = 4 * (64 - ic1);
            const int ca = ia < 128 ? 48 * (128 - ia) : -1, c0 = ic0 < 64 ? 18 * (t0 < nh[0] ? t0 : nh[0]) : -1, c1 = ic1 < 64 ? 18 * (t1 < nh[1] ? t1 : nh[1]) : -1;
            if (ca >= c0 && ca >= c1) { const int qa = 127 - ia; tab[pos++] = (0u << 28) | ((unsigned)(q >> 2) << 24) | ((unsigned)(q & 3) << 16) | (unsigned)qa; ++ia; }
            else if (c0 >= c1) { const int qc = 63 - ic0, bh = 2 * q; tab[pos++] = (2u << 28) | ((unsigned)(bh >> 3) << 24) | ((unsigned)(bh & 7) << 16) | (unsigned)qc; ++ic0; }
            else { const int qc = 63 - ic1, bh = 2 * q + 1; tab[pos++] = (2u << 28) | ((unsigned)(bh >> 3) << 24) | ((unsigned)(bh & 7) << 16) | (unsigned)qc; ++ic1; }
        }
        for (int i = 0; i < 128; ++i) { const int qb = i / 2, bh = 2 * q + (i & 1); tab[256 + i] = (1u << 28) | ((unsigned)(bh >> 3) << 24) | ((unsigned)(bh & 7) << 16) | (unsigned)qb; }
    }
    conv_weights(a, lds, 0, gw, NGW, wave, lane);
    const float* x = a.in[0]; bf16_t* XB = (bf16_t*)(ws + WS_XB); float* rss0 = (float*)(ws + WS_CTL) + CW_RSS;
    for (int mrow = gw; mrow < M; mrow += 2 * NGW) {
        const int mrow2 = mrow + NGW; const bool has2 = mrow2 < M;
        const f32x4* xr = (const f32x4*)(x + (size_t)mrow * D) + lane; const f32x4* xr2 = (const f32x4*)(x + (size_t)(has2 ? mrow2 : mrow) * D) + lane;
        f32x4 xv[4], xw[4];
#pragma unroll
        for (int j = 0; j < 4; ++j) { xv[j] = xr[64 * j]; xw[j] = xr2[64 * j]; }
        unsigned long long* o8 = (unsigned long long*)(XB + (size_t)mrow * D) + lane; unsigned long long* o82 = (unsigned long long*)(XB + (size_t)mrow2 * D) + lane; float s = 0.f, s2 = 0.f;
#pragma unroll
        for (int j = 0; j < 4; ++j) { const f32x4 v = xv[j]; s += (v.x * v.x + v.y * v.y) + (v.z * v.z + v.w * v.w);
            o8[64 * j] = (unsigned long long)pk2(v.x, v.y) | ((unsigned long long)pk2(v.z, v.w) << 32); }
        if (has2) {
#pragma unroll
            for (int j = 0; j < 4; ++j) { const f32x4 v = xw[j]; s2 += (v.x * v.x + v.y * v.y) + (v.z * v.z + v.w * v.w);
                o82[64 * j] = (unsigned long long)pk2(v.x, v.y) | ((unsigned long long)pk2(v.z, v.w) << 32); } }
        s = wave_sum(s); s2 = wave_sum(s2);
        if (lane == 0) { ((unsigned*)rss0)[mrow] = (unsigned)(fminf(s, 1.6e7f) * 256.0f + 0.5f); if (has2) ((unsigned*)rss0)[mrow2] = (unsigned)(fminf(s2, 1.6e7f) * 256.0f + 0.5f); }
    }
}

DI void scan_phase(const Args& a, LAS unsigned char* lds) {
    if (blockIdx.x >= 16) return;
    const int seq = blockIdx.x, b = seq >> 3, h = seq & 7, tid = opaque_tid(), lane = tid & 63, wave = tid >> 6;
    const float* LF = (const float*)(a.ws + WS_LF); float* CK = (float*)(a.ws + WS_CK) + (size_t)seq * SEQ; u32x4* KX = (u32x4*)(a.ws + WS_KX) + (size_t)seq * SEQ;
    LAS float* wt = (LAS float*)lds;
    float v[32]; float run = 0.f;
#pragma unroll
    for (int j = 0; j < 32; ++j) { run += LF[((size_t)b * SEQ + tid * 32 + j) * 8 + h]; v[j] = run; }
    float inc = run;
#pragma unroll
    for (int o = 1; o < 64; o <<= 1) { const float t = __shfl_up(inc, o); if (lane >= o) inc += t; }
    if (lane == 63) wt[wave] = inc;
    __syncthreads();
    float base = inc - run;
    for (int w = 0; w < wave; ++w) base += wt[w];
#pragma unroll
    for (int j = 0; j < 32; ++j) { const float c = v[j] + base; CK[tid * 32 + j] = c;
        const float x = -c; const unsigned h1 = f2bf(x); const float r1 = x - __uint_as_float(h1 << 16); const unsigned h2 = f2bf(r1); const float r2 = r1 - __uint_as_float(h2 << 16); const unsigned h3 = f2bf(r2);
        KX[tid * 32 + j] = (u32x4){h1 | (h2 << 16), h3, 0u, 0u}; }
    __syncthreads();
}

DI void final_phase(const Args& a, int gw, int NGW, int lane) {
    const float* rss = (const float*)(a.ws + WS_CTL) + CW_RSS + 4 * (size_t)M; const f32x4* gf = (const f32x4*)a.in[15] + lane; const bf16_t* XB = (const bf16_t*)(a.ws + WS_XB);
    f32x4 gv[4];
#pragma unroll
    for (int j = 0; j < 4; ++j) gv[j] = gf[64 * j];
    for (int mrow = gw; mrow < M; mrow += NGW) {
        const float rs = pg8::rstd_of(rss, mrow);
        f32x4* xr = (f32x4*)(a.out + (size_t)mrow * D) + lane; const u32x2* xb = (const u32x2*)(XB + (size_t)mrow * D) + lane;
        u32x2 wv[4];
#pragma unroll
        for (int j = 0; j < 4; ++j) wv[j] = xb[64 * j];
#pragma unroll
        for (int j = 0; j < 4; ++j) { const u32x2 w = wv[j]; f32x4 v = (f32x4){__uint_as_float(w.x << 16), __uint_as_float(w.x & 0xffff0000u), __uint_as_float(w.y << 16), __uint_as_float(w.y & 0xffff0000u)}; v = v * rs * gv[j]; xr[64 * j] = v; }
    }
}

__global__ void __launch_bounds__(NWAVES * 64, 2) fwd_kernel(Args a) {
    extern __shared__ __attribute__((aligned(16))) unsigned char lds_raw[];
    LAS unsigned char* lds = (LAS unsigned char*)lds_raw;
    volatile LAS unsigned* bst = (volatile LAS unsigned*)(lds + LDS_BYTES - 16);
    if (threadIdx.x < 4) bst[threadIdx.x] = 0u;
    __syncthreads();
    XcdBarrier xbar; xbar.bar = (unsigned*)(a.ws + WS_CTL) + CW_BAR; xbar.x = 0; xbar.st = bst;
    for (int ph = a.ph_lo; ph < a.ph_hi; ++ph) {
        int G = gridDim.x, bx = blockIdx.x; __attribute__((address_space(1))) unsigned char* wsg = (__attribute__((address_space(1))) unsigned char*)a.ws;
        asm volatile("" : "+s"(G), "+s"(bx), "+s"(wsg));
        unsigned char* ws = (unsigned char*)wsg;
        const int vcu = (G % 8 == 0) ? (bx % 8) * (G / 8) + bx / 8 : bx;
        const int NGW = G * NWAVES;
        const int tid = opaque_tid(), lane = tid & 63, wave = __builtin_amdgcn_readfirstlane(tid >> 6); const int gw = vcu * NWAVES + wave;
        float* rssb = (float*)(ws + WS_CTL) + CW_RSS;
        bf16_t* XB = (bf16_t*)(ws + WS_XB); bf16_t* Qp = (bf16_t*)(ws + WS_QP); bf16_t* Kp = (bf16_t*)(ws + WS_KP); bf16_t* Vp = (bf16_t*)(ws + WS_VP);
        bf16_t* Mg = (bf16_t*)(ws + WS_MG); bf16_t* Gt = (bf16_t*)(ws + WS_G); bf16_t* HID = (bf16_t*)(ws + WS_HID);
        if (ph == 0) {
            { unsigned* ctl = (unsigned*)(ws + WS_CTL); const int gt = gw * 64 + lane, GT = NGW * 64;
              for (int i = gt; i < 12288; i += GT) ctl[i] = 0u;
              for (int i = CW_RSS + M + gt; i < CW_RSS + 5 * M; i += GT) ctl[i] = 0u; }
            if (PH_MASK & 256) prologue(a, lds, gw, NGW, wave, lane); }
        else if (ph == N_PHASES - 1) final_phase(a, gw, NGW, lane);
        else {
            const int l = (ph - 1) / 8, k = (ph - 1) % 8;
            unsigned char* wl = ws + WS_W + (size_t)l * W_LAYER;
            const float* rs_in = rssb + (size_t)(2 * l) * M; float* rs_mid = rssb + (size_t)(2 * l + 1) * M; float* rs_out = rssb + (size_t)(2 * l + 2) * M;
            if (k == 0 && (PH_MASK & 1)) {
                pg8::Gemm g{XB, (const bf16_t*)(wl + W_QKV), M, NQKV, D, D, D}; pg8::StaticOrder S; S.init(M, NQKV, G, bx);
                pg8::EpiQKV E{Qp, rs_in, (float*)(ws + WS_LF), a.in[3] + l * 8, (unsigned*)(ws + WS_CTL) + CW_NRM + 64 * l};
                pg8::gemm_phase<pg8::EpiQKV, pg8::StaticOrder, true>(lds, g, S, E);
            } else if (k == 1 && (PH_MASK & 2)) {
                if (l == 0 && bx >= 16) { const int w2 = __builtin_amdgcn_readfirstlane(opaque_tid() >> 6); conv_weights(a, lds, 1, (bx - 16) * NWAVES + w2, (G - 16) * NWAVES, w2, opaque_tid() & 63); }
                scan_phase(a, lds);
            } else if (k == 2 && (PH_MASK & 4)) {
                att::Params P{Qp, Kp, Vp, (const float*)(ws + WS_CK), (const bf16_t*)(ws + WS_KX), a.in[6], a.in[7] + (size_t)l * 192 * 8, a.in[4] + l * 256, a.in[5] + l * 128,
                              0.8f - 0.6f * expf(-0.3f * (float)l), (unsigned*)(ws + WS_CTL) + CW_QUEUE + 128 * l, (const unsigned*)(ws + WS_ORDER) + l * 8 * 384, (const unsigned*)(ws + WS_CTL) + CW_NRM + 64 * l};
                att::attn_phase(P, (char*)lds_raw);
            } else if (k == 3 && (PH_MASK & 8)) {
                pg8::Gemm g{XB, (const bf16_t*)(wl + W_G), M, 3072, D, D, D}; pg8::StaticOrder S; S.init(M, 3072, G, bx);
                pg8::EpiGate E{Gt, rs_in};
                pg8::gemm_phase<pg8::EpiGate, pg8::StaticOrder, true>(lds, g, S, E);
            } else if (k == 4 && (PH_MASK & 16)) {
                pg8::Gemm g{Qp, (const bf16_t*)(wl + W_BR), M, 3072, 512, PITCH, 512}; pg8::BranchOrder S; S.init(M, G, bx);
                pg8::EpiBranch3 E{Gt, Mg};
                pg8::gemm_phase<pg8::EpiBranch3, pg8::BranchOrder, true>(lds, g, S, E);
            } else if (k == 5 && (PH_MASK & 32)) {
                pg8::Gemm g{Mg, (const bf16_t*)(wl + W_OUT), M, D, D, D, D}; pg8::StaticOrder S; S.init(M, D, G, bx);
                pg8::EpiResid E{l == 0 ? a.in[0] : (const float*)nullptr, XB, (unsigned*)rs_mid};
                pg8::gemm_phase<pg8::EpiResid, pg8::StaticOrder, true>(lds, g, S, E);
            } else if (k == 6 && (PH_MASK & 64)) {
                pg8::Gemm g{XB, (const bf16_t*)(wl + W_GU), M, 2 * DFF, D, D, D}; pg8::StaticOrder S; S.init(M, 2 * DFF, G, bx);
                pg8::EpiSwiglu E{HID, rs_mid};
                pg8::gemm_phase<pg8::EpiSwiglu, pg8::StaticOrder, true>(lds, g, S, E);
            } else if (PH_MASK & 128) {
                pg8::Gemm g{HID, (const bf16_t*)(wl + W_DN), M, D, DFF, DFF, DFF}; pg8::StaticOrder S; S.init(M, D, G, bx);
                pg8::EpiResid E{(const float*)nullptr, XB, (unsigned*)rs_out};
                pg8::gemm_phase<pg8::EpiResid, pg8::StaticOrder, true>(lds, g, S, E);
            }
        }
        if (ph + 1 < a.ph_hi) { if (ph == 0) { cg::this_grid().sync(); xbar = xcd_barrier_post((unsigned*)(a.ws + WS_CTL) + CW_BAR, bst); } else xcd_barrier(xbar); }
    }
}

extern "C" void kernel_launch(void* const* d_in, const int* in_sizes, int n_in, void* d_out, int out_size, void* d_ws, size_t ws_size, hipStream_t stream) {
    static int grid = 0;
    if (grid == 0) {
        if (n_in != 16 || out_size != M * D || ws_size < WS_END) { fprintf(stderr, "kernel_launch: unexpected shapes (n_in %d out %d ws %zu)\n", n_in, out_size, ws_size); grid = -1; return; }
        int dev = 0, cus = 0, per_cu = 0;
        hipGetDevice(&dev); hipDeviceGetAttribute(&cus, hipDeviceAttributeMultiprocessorCount, dev);
        hipFuncSetAttribute((const void*)fwd_kernel, hipFuncAttributeMaxDynamicSharedMemorySize, LDS_BYTES);
        hipOccupancyMaxActiveBlocksPerMultiprocessor(&per_cu, (const void*)fwd_kernel, NWAVES * 64, LDS_BYTES);
        (void)hipGetLastError();
        grid = cus * (per_cu < 1 ? 1 : 1);
    }
    if (grid < 0) return;
    Args a{};
    for (int i = 0; i < 16; ++i) a.in[i] = (const float*)d_in[i];
    a.out = (float*)d_out; a.ws = (unsigned char*)d_ws;
#if MK_ONE_LAUNCH
    a.ph_lo = 0; a.ph_hi = N_PHASES;
    void* args[] = {&a};
    hipError_t e = hipLaunchCooperativeKernel((const void*)fwd_kernel, dim3(grid), dim3(NWAVES * 64), args, LDS_BYTES, stream);
    if (e != hipSuccess) fprintf(stderr, "cooperative launch failed: %s (grid %d)\n", hipGetErrorString(e), grid);
#else
    for (int ph = 0; ph < N_PHASES; ++ph) { a.ph_lo = ph; a.ph_hi = ph + 1; hipLaunchKernelGGL(fwd_kernel, dim3(grid), dim3(NWAVES * 64), LDS_BYTES, stream, a); }
#endif
}
```

```cpp
#include <hip/hip_runtime.h>
#include <hip/hip_cooperative_groups.h>
#include <hip/hip_bf16.h>
#include <cstdio>
#include <cstdint>
#include <cmath>
namespace cg = cooperative_groups;

#ifndef PH_MASK
#define PH_MASK 0x1ff
#endif
#ifndef MK_ONE_LAUNCH
#define MK_ONE_LAUNCH 1
#endif

#define LAS __attribute__((address_space(3)))
#define DI __device__ __forceinline__
typedef unsigned short bf16_t;
typedef short bf16x8 __attribute__((ext_vector_type(8)));
typedef short s16x4 __attribute__((ext_vector_type(4)));
typedef float f32x4 __attribute__((ext_vector_type(4)));
typedef float f32x16 __attribute__((ext_vector_type(16)));
typedef unsigned u32x4 __attribute__((ext_vector_type(4)));
typedef unsigned u32x2 __attribute__((ext_vector_type(2)));
typedef float f32x2_t __attribute__((ext_vector_type(2)));
typedef __bf16 bf16x2_t __attribute__((ext_vector_type(2)));
DI int opaque_tid() { int t = threadIdx.x; asm volatile("" : "+v"(t)); return t; }

constexpr int D = 1024, BATCH = 2, SEQ = 16384, DEPTH = 2, M = BATCH * SEQ;
constexpr int INW = 7688, DFF = 2816;
constexpr int PITCH = 1536;
constexpr int NQKV = 4864;
constexpr float RMS_EPS = 1e-6f;
constexpr float LOG2E = 1.4426950408889634f;
constexpr float C2 = 0.125f * LOG2E;

constexpr size_t MiB = 1u << 20;
constexpr size_t WS_CTL = 0, CTL_BYTES = 1 * MiB;
constexpr size_t WS_ORDER = 1 * MiB;
constexpr size_t WS_LF = 2 * MiB;
constexpr size_t WS_CK = 3 * MiB;
constexpr size_t WS_KX = 4 * MiB;
constexpr size_t WS_W = 8 * MiB;
constexpr size_t W_QKV = 0, W_G = 10 * MiB, W_BR = 16 * MiB, W_OUT = 19 * MiB, W_GU = 21 * MiB, W_DN = 32 * MiB, W_LAYER = 38 * MiB;
constexpr size_t WS_XB = 84 * MiB;
constexpr size_t WS_QP = 148 * MiB, WS_KP = 244 * MiB, WS_VP = 340 * MiB;
constexpr size_t WS_MG = 436 * MiB;
constexpr size_t WS_G = WS_KP;
constexpr size_t WS_HID = WS_KP;
constexpr size_t WS_END = 500 * MiB;
static_assert(WS_W + 2 * W_LAYER <= WS_XB, "weights fit");
constexpr int CW_QUEUE = 0;
constexpr int CW_BAR = 8192;
constexpr int CW_NRM = 1024;
constexpr int CW_RSS = 65536;

constexpr int NUNITS = 3072;

namespace pg8 {
constexpr int BM = 256, BK = 64, HALF = 128, HTB = HALF * BK * 2, STAGE_BYTES = 8 * HTB, NXCD = 8, WGM = 8;
__host__ __device__ __forceinline__ int lds_byte(int r, int c) { const int st = (r >> 4) * 2 + (c >> 5), rr = r & 15, cc = c & 31, ob = rr * 64 + cc * 2; return st * 1024 + (ob ^ (((ob >> 9) & 1) << 5)); }
__host__ __device__ __forceinline__ void stage_rc(int b, int& R, int& C) { const int st = b / 1024, sb = b % 1024, swz = sb ^ (((sb >> 9) & 1) << 5); R = (st >> 1) * 16 + swz / 64; C = (st & 1) * 32 + (swz % 64) / 2; }
__host__ __device__ __forceinline__ int perm32(int rho) { const int n = rho >> 4, i = rho & 15; return 8 * (i >> 2) + 4 * n + (i & 3); }

struct Unit { int pm, pn, aoff; };
struct Gemm { const bf16_t* A; const bf16_t* Bt; int M, N, K, lda, ldb; };

struct StaticOrder {
    int nM, nN, nwg, G, c;
    __device__ void init(int M_, int N_, int G_, int c_) { nM = M_ / BM; nN = N_ / BM; nwg = nM * nN; G = G_; c = c_; }
    __device__ bool tile(long L, int& pm, int& pn) const {
        if (L >= nwg) return false;
        int wgid = (int)L; { const int q = nwg / NXCD, r = nwg % NXCD, xcd = wgid % NXCD, off = wgid / NXCD; wgid = (xcd < r ? xcd * (q + 1) : r * (q + 1) + (xcd - r) * q) + off; }
        const int nig = WGM * nN, gid = wgid / nig, fm = gid * WGM, gsz = (nM - fm) < WGM ? (nM - fm) : WGM;
        pm = fm + ((wgid % nig) % gsz); pn = (wgid % nig) / gsz; return true;
    }
    __device__ bool next(int i, Unit& u) const { u.aoff = 0; return tile((long)i * G + c, u.pm, u.pn); }
};
struct BranchOrder {
    StaticOrder s;
    __device__ void init(int M_, int G_, int c_) { s.init(M_, 1024, G_, c_); }
    __device__ bool next(int i, Unit& u) const {
        const int br = i % 3; int pm, pn;
        if (!s.tile((long)(i / 3) * s.G + s.c, pm, pn)) return false;
        u.pm = pm; u.pn = br * 4 + pn; u.aoff = br * 512 * 2; return true;
    }
};

__device__ __forceinline__ unsigned cvt_pk_bf16(float lo, float hi) { unsigned r; asm volatile("v_cvt_pk_bf16_f32 %0, %1, %2" : "=v"(r) : "v"(lo), "v"(hi)); return r; }

template <class Epi, class Sched, bool ALIGN_EPI>
__device__ __forceinline__ void gemm_phase(LAS unsigned char* lds, const Gemm g, const Sched& S, const Epi& E) {
    const int tid = opaque_tid(), wid = __builtin_amdgcn_readfirstlane(tid >> 6), lane = tid & 63, wr = wid >> 2, wc = wid & 3, fr = lane & 15, fq = lane >> 4;
    const int K = g.K, nt = K / BK;
    unsigned voffA[2], voffB[2];
#pragma unroll
    for (int i = 0; i < 2; ++i) { int R, C; stage_rc(tid * 16 + i * 8192, R, C); const int Rb = Epi::PERM ? ((R & ~31) + perm32(R & 31)) : R;
        voffA[i] = (unsigned)(R * g.lda + C) * 2u; voffB[i] = (unsigned)(Rb * g.ldb + C) * 2u; }
    const size_t kstep = (size_t)(BK * 2);
    const size_t hstepA = (size_t)HALF * g.lda * 2, hstepB = (size_t)HALF * g.ldb * 2;
    const size_t tstepA = 2 * hstepA, tstepB = 2 * hstepB;
    const unsigned ldsw = (unsigned)wid * 1024u;
    const int aoff = lds_byte(wr * 64 + fr, fq * 8), boff = lds_byte(wc * 32 + fr, fq * 8);
#define PG8_SA(b, h) (((b) * 2 + (h)) * HTB)
#define PG8_SB(b, h) ((4 + (b) * 2 + (h)) * HTB)
#define PG8_STAGE(bufoff, gbase, voff) do { _Pragma("unroll") for (int _i = 0; _i < 2; ++_i) \
        __builtin_amdgcn_global_load_lds((const unsigned*)((const char*)(gbase) + (voff)[_i]), (LAS unsigned*)(lds + (bufoff) + ldsw + _i * 8192), 16, 0, 0); } while (0)
#define PG8_LDA(dst, b, h) do { _Pragma("unroll") for (int m = 0; m < 4; ++m) _Pragma("unroll") for (int k = 0; k < 2; ++k) dst[m][k] = *(const LAS bf16x8*)(lds + PG8_SA(b, h) + aoff + m * 2048 + k * 1024); } while (0)
#define PG8_LDB(dst, b, h) do { _Pragma("unroll") for (int n = 0; n < 2; ++n) _Pragma("unroll") for (int k = 0; k < 2; ++k) dst[n][k] = *(const LAS bf16x8*)(lds + PG8_SB(b, h) + boff + n * 2048 + k * 1024); } while (0)
#define PG8_MMA(ai, bj, At, Bt) do { __builtin_amdgcn_s_setprio(1); _Pragma("unroll") for (int m = 0; m < 4; ++m) _Pragma("unroll") for (int n = 0; n < 2; ++n) _Pragma("unroll") for (int k = 0; k < 2; ++k) \
        acc[ai][bj][m][n] = __builtin_amdgcn_mfma_f32_16x16x32_bf16(Bt[n][k], At[m][k], acc[ai][bj][m][n], 0, 0, 0); __builtin_amdgcn_s_setprio(0); } while (0)
#define PG8_WAIT_V(n) asm volatile("s_waitcnt vmcnt(" #n ")" ::: "memory")
#define PG8_WAIT_L(n) asm volatile("s_waitcnt lgkmcnt(" #n ")" ::: "memory")
#define PG8_BAR __builtin_amdgcn_s_barrier()
#define PG8_SCHED __builtin_amdgcn_sched_barrier(0)
    Unit cur, nxt; int ui = 0;
    if (!S.next(0, cur)) return;
    f32x4 acc[2][2][4][2];
#pragma unroll
    for (int a = 0; a < 2; ++a)
#pragma unroll
        for (int b = 0; b < 2; ++b)
#pragma unroll
            for (int m = 0; m < 4; ++m)
#pragma unroll
                for (int n = 0; n < 2; ++n) acc[a][b][m][n] = (f32x4){0.f, 0.f, 0.f, 0.f};
    bf16x8 At[4][2], B0[2][2], B1[2][2];
    const char* cA = (const char*)g.A + (size_t)cur.pm * tstepA + cur.aoff; const char* cB = (const char*)g.Bt + (size_t)cur.pn * tstepB;
    PG8_STAGE(PG8_SB(0, 0), cB, voffB); PG8_STAGE(PG8_SB(0, 1), cB + hstepB, voffB); PG8_STAGE(PG8_SA(0, 0), cA, voffA); PG8_STAGE(PG8_SA(0, 1), cA + hstepA, voffA);
    if (wr == 1) PG8_BAR;
    PG8_WAIT_V(2); PG8_BAR;
    PG8_STAGE(PG8_SB(1, 0), cB + kstep, voffB); PG8_STAGE(PG8_SA(1, 0), cA + kstep, voffA); PG8_STAGE(PG8_SB(1, 1), cB + hstepB + kstep, voffB);
    PG8_WAIT_V(6); PG8_BAR;
    for (;;) {
        const bool has_next = S.next(ui + 1, nxt);
        const char* nA = has_next ? (const char*)g.A + (size_t)nxt.pm * tstepA + nxt.aoff : cA; const char* nB = has_next ? (const char*)g.Bt + (size_t)nxt.pn * tstepB : cB;
        for (int t = 0; t < nt; t += 2) {
            const bool last = (t == nt - 2);
            const char* a1 = cA + (size_t)(t + 1) * kstep;
            const char* a2 = last ? nA : cA + (size_t)(t + 2) * kstep; const char* b2 = last ? nB : cB + (size_t)(t + 2) * kstep;
            const char* a3 = a2 + kstep; const char* b3 = b2 + kstep;
            PG8_LDB(B0, 0, 0); PG8_LDB(B1, 0, 1); PG8_SCHED; PG8_LDA(At, 0, 0); PG8_STAGE(PG8_SA(1, 1), a1 + hstepA, voffA);
            PG8_WAIT_V(8); PG8_WAIT_L(0); PG8_BAR; PG8_MMA(0, 0, At, B0); PG8_MMA(0, 1, At, B1); PG8_BAR; PG8_SCHED;
            PG8_LDA(At, 0, 1); PG8_STAGE(PG8_SB(0, 0), b2, voffB); PG8_STAGE(PG8_SB(0, 1), b2 + hstepB, voffB); PG8_STAGE(PG8_SA(0, 0), a2, voffA);
            PG8_WAIT_V(8); PG8_WAIT_L(0); PG8_BAR; PG8_MMA(1, 0, At, B0); PG8_MMA(1, 1, At, B1); PG8_BAR; PG8_SCHED;
            PG8_LDB(B0, 1, 0); PG8_LDB(B1, 1, 1); PG8_SCHED; PG8_LDA(At, 1, 0); PG8_STAGE(PG8_SA(0, 1), a2 + hstepA, voffA);
            PG8_WAIT_V(8); PG8_WAIT_L(0); PG8_BAR; PG8_MMA(0, 0, At, B0); PG8_MMA(0, 1, At, B1); PG8_BAR; PG8_SCHED;
            PG8_LDA(At, 1, 1); PG8_STAGE(PG8_SB(1, 0), b3, voffB); PG8_STAGE(PG8_SB(1, 1), b3 + hstepB, voffB); PG8_STAGE(PG8_SA(1, 0), a3, voffA);
            PG8_WAIT_V(8); PG8_WAIT_L(0); PG8_BAR; PG8_MMA(1, 0, At, B0); PG8_MMA(1, 1, At, B1); PG8_BAR; PG8_SCHED;
        }
        if constexpr (ALIGN_EPI) { if (wr == 0) PG8_BAR; }
        bool clear_acc = true;
        if constexpr (Epi::FUSE) clear_acc = E.fused(acc, cur, wr, wc, fr, fq); else E(acc, cur, wr, wc, fr, fq);
        if (!has_next) break;
        if (clear_acc) {
#pragma unroll
        for (int a = 0; a < 2; ++a)
#pragma unroll
            for (int b = 0; b < 2; ++b)
#pragma unroll
                for (int m = 0; m < 4; ++m)
#pragma unroll
                    for (int n = 0; n < 2; ++n) acc[a][b][m][n] = (f32x4){0.f, 0.f, 0.f, 0.f};
        }
        cur = nxt; cA = nA; cB = nB; ++ui;
        if constexpr (ALIGN_EPI) { if (wr == 1) PG8_BAR; }
    }
    PG8_WAIT_V(0);
    if constexpr (!ALIGN_EPI) { if (wr == 0) PG8_BAR; }
    PG8_BAR;
#undef PG8_SA
#undef PG8_SB
#undef PG8_STAGE
#undef PG8_LDA
#undef PG8_LDB
#undef PG8_MMA
#undef PG8_WAIT_V
#undef PG8_WAIT_L
#undef PG8_BAR
#undef PG8_SCHED
}

typedef const f32x4 (&AccRef)[2][2][4][2];
__device__ __forceinline__ float rstd_of(const float* rss, int row) { return __builtin_amdgcn_rsqf((float)((const unsigned*)rss)[row] * (1.0f / (256.0f * 1024.0f)) + RMS_EPS); }
__device__ __forceinline__ float sigmoidf_(float x) { return __builtin_amdgcn_rcpf(1.0f + __builtin_amdgcn_exp2f(-x * LOG2E)); }

__device__ __forceinline__ float bflo(unsigned w) { return __uint_as_float(w << 16); }
__device__ __forceinline__ float bfhi(unsigned w) { return __uint_as_float(w & 0xffff0000u); }
struct EpiQKV {
    static constexpr bool PERM = true, FUSE = false;
    bf16_t* Qp; const float* rss; float* LF; const float* bforget; unsigned* nrm;
    __device__ __forceinline__ void operator()(AccRef acc, const Unit& u, int wr, int wc, int fr, int fq) const {
        const int row0 = u.pm * BM + wr * 64 + fr;
        if (u.pn < 18) {
            const int plane = u.pn / 6, colt = (u.pn % 6) * 256; bf16_t* base = Qp + (size_t)plane * ((WS_KP - WS_QP) / 2);
            const float sc = plane == 0 ? C2 : 1.0f; const int col0 = colt + wc * 32 + 8 * fq;
            const bool donrm = (plane < 2) && (colt >= 1024);
            float nmax[2] = {0.f, 0.f};
#pragma unroll
            for (int ai = 0; ai < 2; ++ai)
#pragma unroll
                for (int m = 0; m < 4; ++m) { const int row = row0 + ai * HALF + m * 16; const float rs = rstd_of(rss, row) * sc; bf16_t* rowp = base + (size_t)row * PITCH + col0;
                    const int bb = row >> 14, sq = row & (SEQ - 1), tt = sq >> 6;
#pragma unroll
                    for (int bj = 0; bj < 2; ++bj) { const f32x4 v0 = acc[ai][bj][m][0] * rs, v1 = acc[ai][bj][m][1] * rs; u32x4 w;
                        w.x = cvt_pk_bf16(v0[0], v0[1]); w.y = cvt_pk_bf16(v0[2], v0[3]); w.z = cvt_pk_bf16(v1[0], v1[1]); w.w = cvt_pk_bf16(v1[2], v1[3]);
                        const int col = col0 + bj * HALF;
                        bf16_t* dst = rowp + bj * HALF;
                        if (plane == 1) dst = base + ((((size_t)(bb * 24 + (col >> 6)) * 256 + tt) * 8 + ((col & 63) >> 3)) * 64 + (sq & 63)) * 8;
                        if (plane == 2) dst = base + (((((size_t)(bb * 48 + (col >> 5)) * 256 + tt) * 4 + ((sq & 63) >> 4)) * 16 + (sq & 15)) * 32 + (col & 31));
                        *(u32x4*)dst = w;
                        if (donrm) { float ss = 0.f;
#pragma unroll
                            for (int j = 0; j < 4; ++j) { const float lo = bflo(w[j]), hi = bfhi(w[j]); ss += lo * lo + hi * hi; }
                            ss += __shfl_xor(ss, 16); ss += __shfl_xor(ss, 32); nmax[bj] = fmaxf(nmax[bj], ss); } } }
            if (donrm) {
#pragma unroll
                for (int bj = 0; bj < 2; ++bj) { float v = nmax[bj];
                    v = fmaxf(v, __shfl_xor(v, 1)); v = fmaxf(v, __shfl_xor(v, 2)); v = fmaxf(v, __shfl_xor(v, 4)); v = fmaxf(v, __shfl_xor(v, 8));
                    const int hc = colt - 1024 + bj * HALF + wc * 32;
                    if (fr == 0 && fq == 0) atomicMax(nrm + (((row0 >= SEQ ? 8 : 0) + (hc >> 6)) * 2 + plane) * 2 + ((hc >> 5) & 1), __float_as_uint(v)); } }
        } else if (wc == 0 && fq == 0) {
            f32x4 b0 = *(const f32x4*)(bforget), b1 = *(const f32x4*)(bforget + 4);
#pragma unroll
            for (int ai = 0; ai < 2; ++ai)
#pragma unroll
                for (int m = 0; m < 4; ++m) { const int row = row0 + ai * HALF + m * 16; const float rs = rstd_of(rss, row);
                    f32x4 z0 = acc[ai][0][m][0] * rs + b0, z1 = acc[ai][0][m][1] * rs + b1, o0, o1;
#pragma unroll
                    for (int j = 0; j < 4; ++j) {
                        o0[j] = fminf(z0[j], 0.f) * LOG2E - __builtin_amdgcn_logf(1.0f + __builtin_amdgcn_exp2f(-fabsf(z0[j]) * LOG2E)); o1[j] = fminf(z1[j], 0.f) * LOG2E - __builtin_amdgcn_logf(1.0f + __builtin_amdgcn_exp2f(-fabsf(z1[j]) * LOG2E)); }
                    *(f32x4*)(LF + (size_t)row * 8) = o0; *(f32x4*)(LF + (size_t)row * 8 + 4) = o1; }
        }
    }
};
struct EpiGate {
    static constexpr bool PERM = true, FUSE = false;
    bf16_t* G; const float* rss;
    __device__ __forceinline__ void operator()(AccRef acc, const Unit& u, int wr, int wc, int fr, int fq) const {
        const int row0 = u.pm * BM + wr * 64 + fr, col0 = u.pn * BM + wc * 32 + 8 * fq;
#pragma unroll
        for (int ai = 0; ai < 2; ++ai)
#pragma unroll
            for (int m = 0; m < 4; ++m) { const int row = row0 + ai * HALF + m * 16; const float rs = rstd_of(rss, row); bf16_t* rowp = G + (size_t)row * 3072 + col0;
#pragma unroll
                for (int bj = 0; bj < 2; ++bj) { const f32x4 v0 = acc[ai][bj][m][0] * rs, v1 = acc[ai][bj][m][1] * rs; u32x4 w;
                    w.x = cvt_pk_bf16(sigmoidf_(v0[0]), sigmoidf_(v0[1])); w.y = cvt_pk_bf16(sigmoidf_(v0[2]), sigmoidf_(v0[3]));
                    w.z = cvt_pk_bf16(sigmoidf_(v1[0]), sigmoidf_(v1[1])); w.w = cvt_pk_bf16(sigmoidf_(v1[2]), sigmoidf_(v1[3]));
                    *(u32x4*)(rowp + bj * HALF) = w; } }
    }
};
struct EpiBranch {
    static constexpr bool PERM = true, FUSE = false;
    const bf16_t* G; bf16_t* Mg;
    __device__ __forceinline__ void operator()(AccRef acc, const Unit& u, int wr, int wc, int fr, int fq) const {
        const int br = u.pn >> 2, ct = u.pn & 3;
        const int row0 = u.pm * BM + wr * 64 + fr, col0 = ct * BM + wc * 32 + 8 * fq;
#pragma unroll
        for (int ai = 0; ai < 2; ++ai) {
            u32x4 gwv[4][2], owv[4][2];
#pragma unroll
            for (int m = 0; m < 4; ++m) { const int row = row0 + ai * HALF + m * 16;
                const bf16_t* gp = G + (size_t)row * 3072 + br * 1024 + col0; const bf16_t* mp = Mg + (size_t)row * 1024 + col0;
#pragma unroll
                for (int bj = 0; bj < 2; ++bj) { gwv[m][bj] = *(const u32x4*)(gp + bj * HALF); if (br > 0) owv[m][bj] = *(const u32x4*)(mp + bj * HALF); } }
#pragma unroll
            for (int m = 0; m < 4; ++m) { const int row = row0 + ai * HALF + m * 16; bf16_t* mp = Mg + (size_t)row * 1024 + col0;
#pragma unroll
                for (int bj = 0; bj < 2; ++bj) {
                    const u32x4 gw = gwv[m][bj];
                    f32x4 v0 = acc[ai][bj][m][0], v1 = acc[ai][bj][m][1];
                    v0[0] *= bflo(gw.x); v0[1] *= bfhi(gw.x); v0[2] *= bflo(gw.y); v0[3] *= bfhi(gw.y);
                    v1[0] *= bflo(gw.z); v1[1] *= bfhi(gw.z); v1[2] *= bflo(gw.w); v1[3] *= bfhi(gw.w);
                    if (br > 0) { const u32x4 ow = owv[m][bj];
                        v0[0] += bflo(ow.x); v0[1] += bfhi(ow.x); v0[2] += bflo(ow.y); v0[3] += bfhi(ow.y);
                        v1[0] += bflo(ow.z); v1[1] += bfhi(ow.z); v1[2] += bflo(ow.w); v1[3] += bfhi(ow.w); }
                    u32x4 w; w.x = cvt_pk_bf16(v0[0], v0[1]); w.y = cvt_pk_bf16(v0[2], v0[3]); w.z = cvt_pk_bf16(v1[0], v1[1]); w.w = cvt_pk_bf16(v1[2], v1[3]);
                    *(u32x4*)(mp + bj * HALF) = w; } } }
    }
};
struct EpiBranch3 {
    static constexpr bool PERM = true, FUSE = true;
    const bf16_t* G; bf16_t* Mg;
    __device__ __forceinline__ bool fused(f32x4 (&acc)[2][2][4][2], const Unit& u, int wr, int wc, int fr, int fq) const {
        const int br = u.pn >> 2, ct = u.pn & 3;
        const int row0 = u.pm * BM + wr * 64 + fr, col0 = ct * BM + wc * 32 + 8 * fq;
#pragma unroll
        for (int ai = 0; ai < 2; ++ai) {
            u32x4 gav[4][2], gbv[4][2];
#pragma unroll
            for (int m = 0; m < 4; ++m) { const bf16_t* gp = G + (size_t)(row0 + ai * HALF + m * 16) * 3072 + br * 1024 + col0;
#pragma unroll
                for (int bj = 0; bj < 2; ++bj) { gav[m][bj] = *(const u32x4*)(gp + bj * HALF); if (br < 2) gbv[m][bj] = *(const u32x4*)(gp + 1024 + bj * HALF); } }
#pragma unroll
            for (int m = 0; m < 4; ++m) { bf16_t* mp = Mg + (size_t)(row0 + ai * HALF + m * 16) * 1024 + col0;
#pragma unroll
                for (int bj = 0; bj < 2; ++bj) {
                    const u32x4 ga = gav[m][bj]; float s[8];
                    s[0] = bflo(ga.x); s[1] = bfhi(ga.x); s[2] = bflo(ga.y); s[3] = bfhi(ga.y); s[4] = bflo(ga.z); s[5] = bfhi(ga.z); s[6] = bflo(ga.w); s[7] = bfhi(ga.w);
#pragma unroll
                    for (int j = 0; j < 8; ++j) s[j] = fmaxf(s[j], 1e-18f);
                    if (br < 2) { const u32x4 gb = gbv[m][bj]; float d[8];
                        d[0] = bflo(gb.x); d[1] = bfhi(gb.x); d[2] = bflo(gb.y); d[3] = bfhi(gb.y); d[4] = bflo(gb.z); d[5] = bfhi(gb.z); d[6] = bflo(gb.w); d[7] = bfhi(gb.w);
#pragma unroll
                        for (int j = 0; j < 8; ++j) s[j] *= __builtin_amdgcn_rcpf(fmaxf(d[j], 1e-18f)); }
                    f32x4 v0 = acc[ai][bj][m][0], v1 = acc[ai][bj][m][1];
                    v0[0] *= s[0]; v0[1] *= s[1]; v0[2] *= s[2]; v0[3] *= s[3]; v1[0] *= s[4]; v1[1] *= s[5]; v1[2] *= s[6]; v1[3] *= s[7];
                    if (br < 2) { acc[ai][bj][m][0] = v0; acc[ai][bj][m][1] = v1; }
                    else { u32x4 w; w.x = cvt_pk_bf16(v0[0], v0[1]); w.y = cvt_pk_bf16(v0[2], v0[3]); w.z = cvt_pk_bf16(v1[0], v1[1]); w.w = cvt_pk_bf16(v1[2], v1[3]);
                        *(u32x4*)(mp + bj * HALF) = w; } } } }
        return br == 2;
    }
};
struct EpiResid {
    static constexpr bool PERM = true, FUSE = false;
    const float* xin32; bf16_t* XB; unsigned* rssn;
    __device__ __forceinline__ void operator()(AccRef acc, const Unit& u, int wr, int wc, int fr, int fq) const {
        const int row0 = u.pm * BM + wr * 64 + fr, col0 = u.pn * BM + wc * 32 + 8 * fq;
#pragma unroll
        for (int ai = 0; ai < 2; ++ai) {
            f32x4 xv[4][2][2];
#pragma unroll
            for (int m = 0; m < 4; ++m) { const size_t off = (size_t)(row0 + ai * HALF + m * 16) * 1024 + col0;
#pragma unroll
                for (int bj = 0; bj < 2; ++bj) { const size_t o2 = off + bj * HALF;
                    if (xin32) { xv[m][bj][0] = *(const f32x4*)(xin32 + o2); xv[m][bj][1] = *(const f32x4*)(xin32 + o2 + 4); }
                    else { const u32x4 xw = *(const u32x4*)(XB + o2); xv[m][bj][0] = (f32x4){bflo(xw.x), bfhi(xw.x), bflo(xw.y), bfhi(xw.y)}; xv[m][bj][1] = (f32x4){bflo(xw.z), bfhi(xw.z), bflo(xw.w), bfhi(xw.w)}; } } }
#pragma unroll
            for (int m = 0; m < 4; ++m) { const int row = row0 + ai * HALF + m * 16; const size_t off = (size_t)row * 1024 + col0; float ss = 0.f;
#pragma unroll
                for (int bj = 0; bj < 2; ++bj) { const size_t o2 = off + bj * HALF;
                    const f32x4 x0 = xv[m][bj][0] + acc[ai][bj][m][0], x1 = xv[m][bj][1] + acc[ai][bj][m][1];
                    u32x4 w; w.x = cvt_pk_bf16(x0[0], x0[1]); w.y = cvt_pk_bf16(x0[2], x0[3]); w.z = cvt_pk_bf16(x1[0], x1[1]); w.w = cvt_pk_bf16(x1[2], x1[3]);
                    *(u32x4*)(XB + o2) = w;
                    ss += ((x0[0] * x0[0] + x0[1] * x0[1]) + (x0[2] * x0[2] + x0[3] * x0[3])) + ((x1[0] * x1[0] + x1[1] * x1[1]) + (x1[2] * x1[2] + x1[3] * x1[3])); }
                ss += __shfl_xor(ss, 16); ss += __shfl_xor(ss, 32);
                if (fq == 0) atomicAdd(rssn + row, (unsigned)(fminf(ss, 4.0e6f) * 256.0f + 0.5f)); } }
    }
};
struct EpiSwiglu {
    static constexpr bool PERM = true, FUSE = false;
    bf16_t* H; const float* rss;
    __device__ __forceinline__ void operator()(AccRef acc, const Unit& u, int wr, int wc, int fr, int fq) const {
        const int row0 = u.pm * BM + wr * 64 + fr, col0 = u.pn * 128 + wc * 32 + 8 * fq;
#pragma unroll
        for (int ai = 0; ai < 2; ++ai)
#pragma unroll
            for (int m = 0; m < 4; ++m) { const int row = row0 + ai * HALF + m * 16; const float rs = rstd_of(rss, row);
                float hv[8];
#pragma unroll
                for (int n = 0; n < 2; ++n)
#pragma unroll
                    for (int j = 0; j < 4; ++j) { const float gt = acc[ai][0][m][n][j] * rs, up = acc[ai][1][m][n][j] * rs; hv[n * 4 + j] = gt * sigmoidf_(gt) * up; }
                u32x4 w; w.x = cvt_pk_bf16(hv[0], hv[1]); w.y = cvt_pk_bf16(hv[2], hv[3]); w.z = cvt_pk_bf16(hv[4], hv[5]); w.w = cvt_pk_bf16(hv[6], hv[7]);
                *(u32x4*)(H + (size_t)row * DFF + col0) = w; }
    }
};
}

namespace att {
constexpr int SLOT = 33792;
constexpr int NSLOT = 4, OFF_TAB = NSLOT * SLOT, TAB_BYTES = 8704, OFF_UNIT = OFF_TAB + TAB_BYTES, OFF_VOTE = OFF_UNIT + 64, LDS_BYTES = OFF_VOTE + 128;
typedef LAS const char* lds_cptr;
typedef short v4i16_t __attribute__((ext_vector_type(4)));

DI void glds16(const void* gsrc, unsigned lds_dst) { unsigned keep;
    asm volatile("s_mov_b32 %0, m0\n\ts_mov_b32 m0, %2\n\ts_nop 0\n\tglobal_load_lds_dwordx4 %1, off\n\ts_mov_b32 m0, %0" : "=&s"(keep) : "v"(gsrc), "s"(lds_dst) : "memory"); }
DI unsigned cvtpk(float lo, float hi) { f32x2_t v = {lo, hi}; bf16x2_t b = __builtin_convertvector(v, bf16x2_t); return __builtin_bit_cast(unsigned, b); }
DI s16x4 vtr(lds_cptr p) { return __builtin_bit_cast(s16x4, __builtin_amdgcn_ds_read_tr16_b64_v4i16((LAS v4i16_t*)p)); }
DI float max3f(float a, float b, float c) { float r; asm("v_max3_f32 %0, %1, %2, %3" : "=v"(r) : "v"(a), "v"(b), "v"(c)); return r; }
DI float swapmax(float m) { auto rr = __builtin_amdgcn_permlane32_swap(__float_as_uint(m), __float_as_uint(m), false, false); return fmaxf(__uint_as_float(rr[0]), __uint_as_float(rr[1])); }
DI float swapsum(float m) { auto rr = __builtin_amdgcn_permlane32_swap(__float_as_uint(m), __float_as_uint(m), false, false); return __uint_as_float(rr[0]) + __uint_as_float(rr[1]); }
DI void store_pair16(bf16_t* p_even, int hi, u32x2 a, u32x2 b, bool dry) {
    auto rx = __builtin_amdgcn_permlane32_swap(a.x, b.x, false, false); auto ry = __builtin_amdgcn_permlane32_swap(a.y, b.y, false, false);
    const u32x4 w = (u32x4){(unsigned)rx[0], (unsigned)ry[0], (unsigned)rx[1], (unsigned)ry[1]};
    if (!dry) *(u32x4*)(p_even + 8 * hi) = w;
}
#define ATT_WAIT_BAR() asm volatile("s_waitcnt vmcnt(0) lgkmcnt(0)\n\ts_barrier" ::: "memory")
#define ATT_WAIT_BAR_N(N) asm volatile("s_waitcnt vmcnt(" #N ") lgkmcnt(0)\n\ts_barrier" ::: "memory")

struct Params {
    bf16_t* Qp; const bf16_t* Kp; const bf16_t* Vp; const float* CK; const bf16_t* KX;
    const float* t5; const float* relb; const float* dlam; const float* subg; float lam_init;
    unsigned* counter; const unsigned* order; const unsigned* nrm;
};

template <int KIND> DI void attn_unit(const Params& P, int b, int h, int qb, char* shm, float lam, int& tabtag, bool dry = false) {
    constexpr int NDB = (KIND == 0) ? 4 : 2;
    const int tid = opaque_tid(), lane = tid & 63, r32 = lane & 31, hi = lane >> 5; const int wid = __builtin_amdgcn_readfirstlane(tid >> 6);
    const long rowbase = (long)b * SEQ;
    int qrow0, qoff, T_lo, T_hi, wt_lo, wt_hi; const int m = wid >> 2;
    if (KIND == 0) { qrow0 = qb * 128 + 32 * (wid & 3); qoff = h * 128 + m * 64; T_lo = 0; T_hi = 2 * qb + 1; wt_lo = 0; wt_hi = 2 * qb + ((wid & 3) >> 1); }
    else if (KIND == 1) { qrow0 = qb * 256 + 32 * wid; qoff = 512 + h * 64; const int cq = 4 * qb + (wid >> 1); T_lo = 4 * qb - 8 < 0 ? 0 : 4 * qb - 8; T_hi = 4 * qb + 3; wt_lo = cq - 8 < 0 ? 0 : cq - 8; wt_hi = cq; }
    else { qrow0 = qb * 256 + 32 * wid; qoff = 1024 + h * 64; T_lo = 0; T_hi = 4 * qb + 3; wt_lo = 0; wt_hi = 4 * qb + (wid >> 1); }
    const int kvoff = (KIND == 0) ? h * 128 : qoff;
    const unsigned lds0 = (unsigned)(uintptr_t)shm;
    const lds_cptr shm3 = (lds_cptr)shm;
    const int hk = kvoff >> 6, vb0 = kvoff >> 5;
    const bf16_t* ksrc = P.Kp + ((size_t)(b * 24 + hk) * 256) * 4096 + wid * 512 + lane * 8;
    const bf16_t* vsrc0 = P.Vp + ((size_t)(b * 48 + vb0 + (wid >> 2)) * 256) * 2048 + (wid & 3) * 512 + lane * 8;
    const bf16_t* kxsrc = P.KX + ((size_t)(b * 8 + h) * SEQ + lane) * 8;
#define ATT_DMA(t, so) do { const unsigned sb_ = lds0 + (so); \
        glds16(ksrc + (size_t)(t) * 4096, (unsigned)__builtin_amdgcn_readfirstlane(sb_ + wid * 1024)); \
        if (KIND == 0) glds16(ksrc + (size_t)(t) * 4096 + (size_t)256 * 4096, (unsigned)__builtin_amdgcn_readfirstlane(sb_ + 8192 + wid * 1024)); \
        glds16(vsrc0 + (size_t)(t) * 2048, (unsigned)__builtin_amdgcn_readfirstlane(sb_ + 16384 + wid * 1024)); \
        if (KIND == 0) glds16(vsrc0 + (size_t)(t) * 2048 + (size_t)2 * 256 * 2048, (unsigned)__builtin_amdgcn_readfirstlane(sb_ + 16384 + 8192 + wid * 1024)); \
        if (KIND == 2 && wid == 0) glds16(kxsrc + (size_t)(t) * 64 * 8, (unsigned)__builtin_amdgcn_readfirstlane(sb_ + 32768)); } while (0)
    float cb = 0.f;
    const int want = (KIND << 8) | h;
    if (KIND == 0) { cb = P.t5[15 * 4 + h] * LOG2E;
        if (tabtag != want) for (int i = tid; i < 2175; i += 512) { const int rel = i - 2111; const int n = rel < 0 ? -rel : rel;
            int lg = 36 - __builtin_clz((unsigned)(n | 1)); lg = lg > 15 ? 15 : lg; int idx = n < 8 ? n : lg; idx += rel > 0 ? 16 : 0;
            *(LAS float*)(shm3 + OFF_TAB + i * 4) = P.t5[idx * 4 + h] * LOG2E - cb; } }
    if (KIND == 1) { cb = P.relb[h] * LOG2E;
        if (tabtag != want && tid < 255) { int idx = tid - 191; idx = idx < -128 ? -128 : idx; *(LAS float*)(shm3 + OFF_TAB + tid * 4) = P.relb[(idx + 128) * 8 + h] * LOG2E - cb; } }
    if (KIND != 2) tabtag = want;
    const int NT = T_hi - T_lo + 1;
#define ATT_TILE(i) ((KIND == 2) ? T_hi - (i) : T_lo + (i))
    ATT_DMA(ATT_TILE(0), 0);
    if (NT > 1) ATT_DMA(ATT_TILE(1), SLOT);
    if (NT > 2) ATT_DMA(ATT_TILE(2), 2 * SLOT);
    bf16x8 qr[4];
    { const bf16_t* qp = P.Qp + (rowbase + qrow0 + r32) * PITCH + qoff + hi * 8;
#pragma unroll
      for (int d0 = 0; d0 < 4; ++d0) qr[d0] = *(const bf16x8*)(qp + d0 * 16); }
    float qkmax = 0.f;
    if (KIND == 2) { cb = P.CK[(size_t)(b * 8 + h) * SEQ + qrow0 + r32]; const unsigned* np = P.nrm + (b * 8 + h) * 4; qkmax = (sqrtf(__uint_as_float(np[0]) * __uint_as_float(np[2])) + sqrtf(__uint_as_float(np[1]) * __uint_as_float(np[3]))) * 1.001f + 0.01f; }
    asm volatile("" : "+v"(qr[0]), "+v"(qr[1]), "+v"(qr[2]), "+v"(qr[3]), "+v"(cb), "+v"(qkmax));
    bf16x8 ones = (bf16x8){0, 0, 0, 0, 0, 0, 0, 0}; if (KIND == 2 && hi == 0) { ones[0] = 0x3F80; ones[1] = 0x3F80; ones[2] = 0x3F80; }
    float mhat = 0.f, lsum = 0.f; f32x16 o[NDB]; f32x16 negm;
#pragma unroll
    for (int i = 0; i < NDB; ++i) o[i] = f32x16{};
#pragma unroll
    for (int r = 0; r < 16; ++r) negm[r] = cb;
    const int vlane = ((lane >> 4) & 1) * 32 + (lane & 3) * 8 + (4 * hi + ((lane & 15) >> 2)) * 64;
    LAS unsigned* vote = (LAS unsigned*)(shm3 + OFF_VOTE);
    if (KIND == 2 && tid < 32) vote[tid] = 0u;
    ATT_WAIT_BAR();
    int sc = 0, sd = 3 * SLOT;
    int nt_eff = NT;
#define SBAR() __builtin_amdgcn_sched_barrier(0)
#define PIN(x) asm volatile("" : "+v"(x))
#define MF(a_, b_, c_) __builtin_amdgcn_mfma_f32_32x32x16_bf16(a_, b_, c_, 0, 0, 0)
#define EX(v) __builtin_amdgcn_exp2f(v)
#define ATT_KLD(so_, h_) do { const lds_cptr kb_ = shm3 + (so_) + ((KIND == 0) ? m * 8192 : 0) + hi * 1024 + r32 * 16 + (h_) * 4096; \
        kf[0] = *(const LAS bf16x8*)(kb_); kf[1] = *(const LAS bf16x8*)(kb_ + 512); kf[2] = *(const LAS bf16x8*)(kb_ + 2048); kf[3] = *(const LAS bf16x8*)(kb_ + 2560); } while (0)
#define ATT_XLD(so_) do { if (KIND == 2) { const lds_cptr xb_ = shm3 + (so_) + 32768 + r32 * 16; x0 = *(const LAS bf16x8*)(xb_); x1 = *(const LAS bf16x8*)(xb_ + 512); if (hi) { x0 = (bf16x8){0, 0, 0, 0, 0, 0, 0, 0}; x1 = x0; } } } while (0)
#define ATT_FIX(P0, P1, t_) do { const int tt_ = (t_); \
        if (KIND == 0 && (tt_ * 64 + 63 - qrow0) > -2048) { const lds_cptr tp = shm3 + OFF_TAB + (tt_ * 64 - qrow0 - r32 + 4 * hi + 2111) * 4; \
            _Pragma("unroll") for (int r = 0; r < 16; ++r) { P0[r] += *(LAS const float*)(tp + 4 * ((r & 3) + 8 * (r >> 2))); P1[r] += *(LAS const float*)(tp + 4 * ((r & 3) + 8 * (r >> 2) + 32)); } } \
        if (KIND == 1 && tt_ >= (qrow0 >> 6) - 2) { const lds_cptr tp = shm3 + OFF_TAB + (tt_ * 64 - qrow0 - r32 + 4 * hi + 191) * 4; \
            _Pragma("unroll") for (int r = 0; r < 16; ++r) { P0[r] += *(LAS const float*)(tp + 4 * ((r & 3) + 8 * (r >> 2))); P1[r] += *(LAS const float*)(tp + 4 * ((r & 3) + 8 * (r >> 2) + 32)); } } \
        if (KIND == 2 && tt_ == wt_hi) { const int ql = (qrow0 & 63) + r32; \
            _Pragma("unroll") for (int r = 0; r < 16; ++r) { const int kv = (r & 3) + 8 * (r >> 2) + 4 * hi; if (kv > ql) P0[r] = -INFINITY; if (kv + 32 > ql) P1[r] = -INFINITY; } } \
        if (tt_ < wt_lo || tt_ > wt_hi) { _Pragma("unroll") for (int r = 0; r < 16; ++r) { P0[r] = -INFINITY; P1[r] = -INFINITY; } } } while (0)
#define ATT_DECIDE(P0, P1, rm_) do { if (__any((rm_) > 6.0f)) { const float dl = fmaxf((rm_), 0.f); mhat += dl; const float f = EX(-dl); lsum *= f; \
            _Pragma("unroll") for (int r = 0; r < 16; ++r) { P0[r] -= dl; P1[r] -= dl; negm[r] -= dl; } \
            _Pragma("unroll") for (int i2 = 0; i2 < NDB; ++i2) _Pragma("unroll") for (int r = 0; r < 16; ++r) o[i2][r] *= f; } } while (0)
#define ATT_STEP_BAR(i) do { if ((i) >= 1 && (i) + 2 < NT) { if (KIND == 0) ATT_WAIT_BAR_N(4); else if (KIND == 2 && wid == 0) ATT_WAIT_BAR_N(3); else ATT_WAIT_BAR_N(2); } else ATT_WAIT_BAR(); \
        if ((i) + 3 < NT) ATT_DMA(ATT_TILE((i) + 3), sd); \
        if (KIND == 2 && (i) >= 1) { const u32x4 v0 = *(const LAS u32x4*)(vote + 8 * (((i) - 1) & 3)), v1 = *(const LAS u32x4*)(vote + 8 * (((i) - 1) & 3) + 4); \
            if ((v0.x & v0.y & v0.z & v0.w & v1.x & v1.y & v1.z & v1.w) != 0u && (i) + 1 < nt_eff) nt_eff = (i) + 1; } } while (0)
    f32x16 pa0, pa1, pb0, pb1;
    bf16x8 kf[4], x0, x1;
    ATT_KLD(0, 0); ATT_XLD(0);
    pa0 = MF(kf[0], qr[0], negm); pa1 = MF(kf[1], qr[0], negm); pa0 = MF(kf[2], qr[1], pa0); pa1 = MF(kf[3], qr[1], pa1);
    SBAR(); ATT_KLD(0, 1); SBAR();
    pa0 = MF(kf[0], qr[2], pa0); pa1 = MF(kf[1], qr[2], pa1); pa0 = MF(kf[2], qr[3], pa0); pa1 = MF(kf[3], qr[3], pa1);
    if (KIND == 2) { pa0 = MF(x0, ones, pa0); pa1 = MF(x1, ones, pa1); }
    ATT_FIX(pa0, pa1, ATT_TILE(0));
    { float rm = max3f(pa0[0], pa0[1], pa1[0]), rm2 = max3f(pa0[2], pa0[3], pa1[1]); rm = max3f(rm, pa1[2], pa1[3]);
#pragma unroll
      for (int r = 4; r < 16; r += 4) { rm = max3f(rm, pa0[r], pa0[r + 1]); rm2 = max3f(rm2, pa0[r + 2], pa0[r + 3]); rm = max3f(rm, pa1[r], pa1[r + 1]); rm2 = max3f(rm2, pa1[r + 2], pa1[r + 3]); }
      rm = swapmax(max3f(rm, rm2, rm2)); ATT_DECIDE(pa0, pa1, rm); }
    for (int i = 0; i < nt_eff; ++i) {
        ATT_STEP_BAR(i);
        const int sn = (sc == 3 * SLOT) ? 0 : sc + SLOT;
        const lds_cptr vp = shm3 + sc + 16384 + vlane;
        bf16x8 vq[4]; bf16x8 pw[4]; u32x4 w0, w1; float sacc = 0.f;
#define LDV(j_) do { if ((j_) < 4 * NDB) { const lds_cptr a_ = vp + ((j_) % NDB) * 4096 + ((j_) / NDB) * 1024; const s16x4 lo_ = vtr(a_), hi_ = vtr(a_ + 512); \
            vq[(j_) & 3] = (bf16x8){lo_[0], lo_[1], lo_[2], lo_[3], hi_[0], hi_[1], hi_[2], hi_[3]}; } } while (0)
#define PVM(j_) o[(j_) % NDB] = MF(vq[(j_) & 3], pw[(j_) / NDB], o[(j_) % NDB])
        ATT_KLD(sn, 0); ATT_XLD(sn);
        SBAR();
#define G1(MFMA_, a_, W_, j_) do { MFMA_; pa0[a_] = EX(pa0[a_]); pa0[a_ + 1] = EX(pa0[a_ + 1]); sacc += pa0[a_]; sacc += pa0[a_ + 1]; W_[j_] = cvtpk(pa0[a_], pa0[a_ + 1]); PIN(pa0); PIN(sacc); PIN(W_); SBAR(); } while (0)
        G1(pb0 = MF(kf[0], qr[0], negm), 0, w0, 0);  G1(pb1 = MF(kf[1], qr[0], negm), 2, w0, 1);
        G1(pb0 = MF(kf[2], qr[1], pb0), 4, w0, 2);   G1(pb1 = MF(kf[3], qr[1], pb1), 6, w0, 3);
        ATT_KLD(sn, 1);
        SBAR();
        G1(pb0 = MF(kf[0], qr[2], pb0), 8, w1, 0);   G1(pb1 = MF(kf[1], qr[2], pb1), 10, w1, 1);
        LDV(0); SBAR();
        G1(pb0 = MF(kf[2], qr[3], pb0), 12, w1, 2);
        LDV(1); SBAR();
        G1(pb1 = MF(kf[3], qr[3], pb1), 14, w1, 3);
        LDV(2); SBAR();
#undef G1
        if (KIND == 2) { pb0 = MF(x0, ones, pb0); pb1 = MF(x1, ones, pb1); }
        pw[0] = __builtin_bit_cast(bf16x8, w0); pw[1] = __builtin_bit_cast(bf16x8, w1);
#define E4(a_, W_, j_) do { pa1[a_] = EX(pa1[a_]); pa1[a_ + 1] = EX(pa1[a_ + 1]); sacc += pa1[a_]; sacc += pa1[a_ + 1]; W_[j_] = cvtpk(pa1[a_], pa1[a_ + 1]); } while (0)
        if (NDB == 4) {
            LDV(3); PVM(0); E4(0, w0, 0); PIN(pa1); PIN(sacc); PIN(w0); SBAR();
            LDV(4); PVM(1); E4(2, w0, 1); PIN(pa1); PIN(sacc); PIN(w0); SBAR();
            LDV(5); PVM(2); E4(4, w0, 2); PIN(pa1); PIN(sacc); PIN(w0); SBAR();
            LDV(6); PVM(3); E4(6, w0, 3); PIN(pa1); PIN(sacc); PIN(w0); SBAR();
            LDV(7); PVM(4); E4(8, w1, 0); PIN(pa1); PIN(sacc); PIN(w1); SBAR();
            LDV(8); PVM(5); E4(10, w1, 1); PIN(pa1); PIN(sacc); PIN(w1); SBAR();
            LDV(9); PVM(6); E4(12, w1, 2); PIN(pa1); PIN(sacc); PIN(w1); SBAR();
            LDV(10); PVM(7); E4(14, w1, 3); PIN(pa1); PIN(sacc); PIN(w1); SBAR();
        } else {
            LDV(3); PVM(0); E4(0, w0, 0); E4(2, w0, 1); PIN(pa1); PIN(sacc); PIN(w0); SBAR();
            LDV(4); PVM(1); E4(4, w0, 2); E4(6, w0, 3); PIN(pa1); PIN(sacc); PIN(w0); SBAR();
            LDV(5); PVM(2); E4(8, w1, 0); E4(10, w1, 1); PIN(pa1); PIN(sacc); PIN(w1); SBAR();
            LDV(6); PVM(3); E4(12, w1, 2); E4(14, w1, 3); PIN(pa1); PIN(sacc); PIN(w1); SBAR();
        }
#undef E4
        pw[2] = __builtin_bit_cast(bf16x8, w0); pw[3] = __builtin_bit_cast(bf16x8, w1);
        lsum += sacc;
        ATT_FIX(pb0, pb1, ATT_TILE(i + 1));
        float rm, rm2;
        if (NDB == 4) {
            LDV(11); PVM(8); rm = max3f(pb0[0], pb0[1], pb1[0]); rm2 = max3f(pb0[2], pb0[3], pb1[1]); PIN(rm); PIN(rm2); SBAR();
            LDV(12); PVM(9); rm = max3f(rm, pb1[2], pb1[3]); rm2 = max3f(rm2, pb0[4], pb0[5]); PIN(rm); PIN(rm2); SBAR();
            LDV(13); PVM(10); rm = max3f(rm, pb0[6], pb0[7]); rm2 = max3f(rm2, pb1[4], pb1[5]); PIN(rm); PIN(rm2); SBAR();
            LDV(14); PVM(11); rm = max3f(rm, pb1[6], pb1[7]); rm2 = max3f(rm2, pb0[8], pb0[9]); PIN(rm); PIN(rm2); SBAR();
            LDV(15); PVM(12); rm = max3f(rm, pb0[10], pb0[11]); rm2 = max3f(rm2, pb1[8], pb1[9]); PIN(rm); PIN(rm2); SBAR();
            PVM(13); rm = max3f(rm, pb1[10], pb1[11]); rm2 = max3f(rm2, pb0[12], pb0[13]); PIN(rm); PIN(rm2); SBAR();
            PVM(14); rm = max3f(rm, pb0[14], pb0[15]); rm2 = max3f(rm2, pb1[12], pb1[13]); PIN(rm); PIN(rm2); SBAR();
            PVM(15); rm = max3f(rm, pb1[14], pb1[15]); PIN(rm); SBAR();
        } else {
            LDV(7); PVM(4); rm = max3f(pb0[0], pb0[1], pb1[0]); rm2 = max3f(pb0[2], pb0[3], pb1[1]); rm = max3f(rm, pb1[2], pb1[3]); rm2 = max3f(rm2, pb0[4], pb0[5]); PIN(rm); PIN(rm2); SBAR();
            PVM(5); rm = max3f(rm, pb0[6], pb0[7]); rm2 = max3f(rm2, pb1[4], pb1[5]); rm = max3f(rm, pb1[6], pb1[7]); rm2 = max3f(rm2, pb0[8], pb0[9]); PIN(rm); PIN(rm2); SBAR();
            PVM(6); rm = max3f(rm, pb0[10], pb0[11]); rm2 = max3f(rm2, pb1[8], pb1[9]); rm = max3f(rm, pb1[10], pb1[11]); rm2 = max3f(rm2, pb0[12], pb0[13]); PIN(rm); PIN(rm2); SBAR();
            PVM(7); rm = max3f(rm, pb0[14], pb0[15]); rm2 = max3f(rm2, pb1[12], pb1[13]); rm = max3f(rm, pb1[14], pb1[15]); PIN(rm); PIN(rm2); SBAR();
        }
#undef LDV
#undef PVM
        rm = swapmax(max3f(rm, rm2, rm2));
        if (KIND == 2) {
            const u32x2 kx = *(const LAS u32x2*)(shm3 + sc + 32768);
            const float xk0 = __uint_as_float(kx.x << 16) + __uint_as_float(kx.x & 0xffff0000u) + __uint_as_float(kx.y << 16);
            const float ltot = swapsum(lsum);
            const bool ok = (qkmax + cb + xk0) < (mhat + __builtin_amdgcn_logf(ltot) - 54.0f);
            const bool allok = __all(ok) && !(ATT_TILE(i) > wt_hi);
            if (lane == 0) vote[8 * (i & 3) + wid] = allok ? 1u : 0u;
        }
        if (i + 1 < nt_eff) ATT_DECIDE(pb0, pb1, rm);
        pa0 = pb0; pa1 = pb1;
        sc = sn; sd = (sd == 3 * SLOT) ? 0 : sd + SLOT;
    }
#undef ATT_STEP_BAR
#undef ATT_TILE
#undef ATT_KLD
#undef ATT_XLD
#undef ATT_FIX
#undef ATT_DECIDE
#undef SBAR
#undef PIN
#undef MF
#undef EX
    const float rl = __builtin_amdgcn_rcpf(swapsum(lsum));
    bf16_t* orow = P.Qp + (rowbase + qrow0 + r32) * PITCH + ((KIND == 0) ? h * 128 : qoff);
    ATT_WAIT_BAR();
    if (KIND == 0) {
        LAS float* comb = (LAS float*)shm3 + (size_t)(wid & 3) * 4096 + lane;
        if (m == 1) {
#pragma unroll
            for (int db = 0; db < NDB; ++db)
#pragma unroll
                for (int r = 0; r < 16; ++r) comb[(db * 16 + r) * 64] = o[db][r] * rl;
        }
        ATT_WAIT_BAR();
        if (m == 0) {
            float ss = 0.f;
#pragma unroll
            for (int db = 0; db < NDB; ++db)
#pragma unroll
                for (int r = 0; r < 16; ++r) { const float d = o[db][r] * rl - lam * comb[(db * 16 + r) * 64]; o[db][r] = d; ss += d * d; }
            ss = swapsum(ss);
            const float sc = __builtin_amdgcn_rsqf(ss * (1.0f / 128.0f) + RMS_EPS) * (1.0f - P.lam_init);
#pragma unroll
            for (int db = 0; db < NDB; ++db)
#pragma unroll
                for (int g = 0; g < 4; g += 2) { u32x2 wp[2];
#pragma unroll
                    for (int e = 0; e < 2; ++e) { const f32x4 sg = *(const f32x4*)(P.subg + db * 32 + 8 * (g + e) + 4 * hi); const int r = 4 * (g + e);
                        wp[e].x = cvtpk(o[db][r] * sc * sg[0], o[db][r + 1] * sc * sg[1]); wp[e].y = cvtpk(o[db][r + 2] * sc * sg[2], o[db][r + 3] * sc * sg[3]); }
                    store_pair16(orow + db * 32 + 8 * g, hi, wp[0], wp[1], dry); }
        }
        ATT_WAIT_BAR();
    } else {
#pragma unroll
        for (int db = 0; db < NDB; ++db)
#pragma unroll
            for (int g = 0; g < 4; g += 2) { u32x2 wp[2];
#pragma unroll
                for (int e = 0; e < 2; ++e) { const int r = 4 * (g + e); wp[e].x = cvtpk(o[db][r] * rl, o[db][r + 1] * rl); wp[e].y = cvtpk(o[db][r + 2] * rl, o[db][r + 3] * rl); }
                store_pair16(orow + db * 32 + 8 * g, hi, wp[0], wp[1], dry); }
    }
#undef ATT_DMA
}

DI void attn_phase(const Params& P, char* shm) {
    const int tid = opaque_tid(), lane = tid & 63;
    float lam;
    { const float a = P.dlam[lane] * P.dlam[64 + lane], c = P.dlam[128 + lane] * P.dlam[192 + lane]; float sa = a, sc = c;
#pragma unroll
      for (int o = 1; o < 64; o <<= 1) { sa += __shfl_xor(sa, o); sc += __shfl_xor(sc, o); }
      lam = __builtin_amdgcn_exp2f(sa * LOG2E) - __builtin_amdgcn_exp2f(sc * LOG2E) + P.lam_init; }
    LAS unsigned* su = (LAS unsigned*)((att::lds_cptr)shm + OFF_UNIT);
    int tabtag = -1;
    if (tid >= 256) __builtin_amdgcn_s_setprio(1);
    const unsigned xcd = (unsigned)__builtin_amdgcn_s_getreg((3 << 11) | 20) & 7u;
    for (unsigned k = 0; k < 8; ++k) {
        const unsigned q = (xcd + k) & 7u; unsigned* cnt = P.counter + 16 * q;
        for (;;) {
            if (tid == 0) su[0] = atomicAdd(cnt, 1u);
            ATT_WAIT_BAR();
            const unsigned ui = su[0];
            ATT_WAIT_BAR();
            if (ui >= 384u) break;
            const unsigned e = P.order[q * 384 + ui]; const int kind = e >> 28, b = (e >> 24) & 15, h = (e >> 16) & 255, qb = e & 0xffff;
#if defined(PROBE_REP_A) || defined(PROBE_REP_C)
            { const int reps = (kind == 0) ? PROBE_REP_A : (kind == 2 ? PROBE_REP_C : 1);
              for (int rep = 1; rep < reps; ++rep) { if (kind == 0) attn_unit<0>(P, b, h, qb, shm, lam, P.lam_init > -1.0f); else attn_unit<2>(P, b, h, qb, shm, lam, P.lam_init > -1.0f); ATT_WAIT_BAR(); } }
#endif
            if (kind == 0) attn_unit<0>(P, b, h, qb, shm, lam, tabtag);
            else if (kind == 1) attn_unit<1>(P, b, h, qb, shm, lam, tabtag);
            else attn_unit<2>(P, b, h, qb, shm, lam, tabtag);
            ATT_WAIT_BAR();
        }
    }
    __builtin_amdgcn_s_setprio(0);
}
}

#define XB_TMO      128
#define XB_XCNT(j)  (256  + 64 * (j))
#define XB_XSUB(j)  (1280 + 64 * (j))
#define XB_XGEN(j)  (2304 + 64 * (j))
#define XB_TOP      3328
#define XB_TOPGEN   3392
#define XCD_BAR_WORDS 3456
#define XB_SPIN_CAP (1u << 18)

__device__ __forceinline__ unsigned xb_ld(unsigned* p)              { return __hip_atomic_load(p, __ATOMIC_RELAXED, __HIP_MEMORY_SCOPE_AGENT); }
__device__ __forceinline__ unsigned xb_add(unsigned* p, unsigned v) { return __hip_atomic_fetch_add(p, v, __ATOMIC_RELAXED, __HIP_MEMORY_SCOPE_AGENT); }
__device__ __forceinline__ unsigned xb_xcc_id() { return (unsigned)__builtin_amdgcn_s_getreg((3 << 11) | 20) & 0xFu; }
#define XB_SPIN(cond, bar) do { unsigned _sp = 0; while (cond) { __builtin_amdgcn_s_sleep(1); \
    if ((++_sp & 255u) == 0u) { if (xb_ld(&(bar)[XB_TMO])) break; if (_sp > XB_SPIN_CAP) { atomicAdd(&(bar)[XB_TMO], 1u); break; } } } } while (0)

struct XcdBarrier {
    unsigned* bar; unsigned x;
    volatile LAS unsigned* st;
};

__device__ __forceinline__ XcdBarrier xcd_barrier_post(unsigned* bar, volatile LAS unsigned* st) {
    XcdBarrier b; b.bar = bar; b.x = xb_xcc_id(); b.st = st;
    if (threadIdx.x == 0) (void)xb_add(&bar[XB_XCNT(b.x)], 1u);
    return b;
}
__device__ __forceinline__ void xcd_barrier_complete(unsigned* bar, unsigned x, unsigned& nloc, unsigned& nx) {
    const unsigned G = gridDim.x * gridDim.y * gridDim.z;
    unsigned sum, cnt, mine, sp = 0u;
    for (;;) {
        sum = 0u; cnt = 0u; mine = 0u;
#pragma unroll
        for (unsigned j = 0; j < 16; ++j) { const unsigned c = xb_ld(&bar[XB_XCNT(j)]); sum += c; cnt += (c > 0u) ? 1u : 0u; mine = (j == x) ? c : mine; }
        if (sum == G) break;
        __builtin_amdgcn_s_sleep(1);
        if ((++sp & 255u) == 0u) { if (xb_ld(&bar[XB_TMO])) break; if (sp > XB_SPIN_CAP) { atomicAdd(&bar[XB_TMO], 1u); break; } }
    }
    nloc = mine > 0u ? mine : 1u; nx = cnt > 0u ? cnt : 1u;
}

__device__ __forceinline__ void xcd_barrier(const XcdBarrier& b) {
    asm volatile("s_waitcnt vmcnt(0)" ::: "memory");
    __syncthreads();
    if (threadIdx.x == 0) {
        unsigned* bar = b.bar;
        __builtin_amdgcn_s_waitcnt(0);
        unsigned nloc = b.st[0], nx = b.st[1];
        if (nloc == 0u) { xcd_barrier_complete(bar, b.x, nloc, nx); b.st[0] = nloc; b.st[1] = nx; }
        const unsigned old = xb_add(&bar[XB_XSUB(b.x)], 1u);
        const unsigned gen = old / nloc;
        if (old + 1u == (gen + 1u) * nloc) {
            __builtin_amdgcn_fence(__ATOMIC_RELEASE, "agent");
            asm volatile("s_waitcnt vmcnt(0)" ::: "memory");
            const unsigned og = xb_add(&bar[XB_TOP], 1u);
            const unsigned tg = og / nx;
            if (og + 1u == (tg + 1u) * nx) xb_add(&bar[XB_TOPGEN], 1u);
            else XB_SPIN(xb_ld(&bar[XB_TOPGEN]) == tg, bar);
            __builtin_amdgcn_fence(__ATOMIC_ACQUIRE, "agent");
            xb_add(&bar[XB_XGEN(b.x)], 1u);
            asm volatile("s_waitcnt vmcnt(0)" ::: "memory");
        } else {
            XB_SPIN(xb_ld(&bar[XB_XGEN(b.x)]) == gen, bar);
            __builtin_amdgcn_fence(__ATOMIC_ACQUIRE, "agent");
            asm volatile("s_waitcnt vmcnt(0)" ::: "memory");
        }
    }
    __syncthreads();
}

constexpr int NWAVES = 8;
constexpr int LDS_BYTES = 147456;

struct Args {
    const float* in[16]; float* out; unsigned char* ws; int ph_lo, ph_hi;
};
constexpr int N_PHASES = 18;

DI float wave_sum(float v) {
#pragma unroll
    for (int o = 1; o < 64; o <<= 1) v += __shfl_xor(v, o);
    return v;
}
DI unsigned f2bf(float f) { unsigned u = __builtin_bit_cast(unsigned, f); return (u + 0x7fffu + ((u >> 16) & 1u)) >> 16; }
DI unsigned pk2(float lo, float hi) { return f2bf(lo) | (f2bf(hi) << 16); }

DI void conv_item(const float* W, int ldw, int src_col0, int k0, const float* gv, bf16_t* WT, int ldt, int dst_row0, LAS float* scr, int lane) {
    { f32x4 wv[8]; float gs[8];
#pragma unroll
      for (int i = 0; i < 8; ++i) { const int kk = 8 * i + (lane >> 3); wv[i] = *(const f32x4*)(W + (size_t)(k0 + kk) * ldw + src_col0 + (lane & 7) * 4); gs[i] = gv ? gv[k0 + kk] : 1.0f; }
#pragma unroll
      for (int i = 0; i < 8; ++i) { const int kk = 8 * i + (lane >> 3); LAS float* d = scr + kk * 33 + (lane & 7) * 4; const f32x4 v = wv[i] * gs[i]; d[0] = v.x; d[1] = v.y; d[2] = v.z; d[3] = v.w; } }
    asm volatile("s_waitcnt lgkmcnt(0)" ::: "memory");
    const int c = lane & 7;
#pragma unroll
    for (int j = 0; j < 4; ++j) { const int n = (lane >> 3) + 8 * j; const LAS float* s = scr + (8 * c) * 33 + n;
        u32x4 o; o.x = pk2(s[0 * 33], s[1 * 33]); o.y = pk2(s[2 * 33], s[3 * 33]); o.z = pk2(s[4 * 33], s[5 * 33]); o.w = pk2(s[6 * 33], s[7 * 33]);
        *(u32x4*)(WT + (size_t)(dst_row0 + n) * ldt + k0 + 8 * c) = o; }
    asm volatile("s_waitcnt lgkmcnt(0)" ::: "memory");
}

DI void conv_weights(const Args& a, LAS unsigned char* lds, int l, int gw, int NGW, int wave, int lane) {
    unsigned char* ws = a.ws;
    LAS float* scr = (LAS float*)(lds + wave * 16384);
    constexpr int I_QKV = 9 * 256, I_CF = 256, I_G = 16 * 96, I_BR = 3 * 256, I_OUT = 512, I_GU = 16 * 176, I_DN = 44 * 32;
    constexpr int I_LAYER = I_QKV + I_CF + I_G + I_BR + I_OUT + I_GU + I_DN;
    for (int it = gw; it < I_LAYER; it += NGW) {
        int r = it;
        unsigned char* wl = ws + WS_W + (size_t)l * W_LAYER;
        const float* w_in = a.in[2] + (size_t)l * D * INW; const float* gmix = a.in[1] + l * D;
        if (r < I_QKV) { const int grp = r / 256, q = r % 256, kb = q / 16, nb = q % 16;
            const int srcs[9] = {0, 1536, 3072, 512, 2048, 3584, 1024, 2560, 4096};
            int sc = 0;
#pragma unroll
            for (int i = 0; i < 9; ++i) sc = (grp == i) ? srcs[i] : sc;
            conv_item(w_in, INW, sc + nb * 32, kb * 64, gmix, (bf16_t*)(wl + W_QKV), D, grp * 512 + nb * 32, scr, lane); continue; } r -= I_QKV;
        if (r < I_CF) { bf16_t* dst = (bf16_t*)(wl + W_QKV) + (size_t)(4608 + r) * D;
            for (int k = lane; k < D; k += 64) dst[k] = (r < 8) ? (bf16_t)f2bf(w_in[(size_t)k * INW + 4608 + r] * gmix[k]) : (bf16_t)0; continue; } r -= I_CF;
        if (r < I_G) { const int kb = r / 96, nb = r % 96; conv_item(w_in, INW, 4616 + nb * 32, kb * 64, gmix, (bf16_t*)(wl + W_G), D, nb * 32, scr, lane); continue; } r -= I_G;
        if (r < I_BR) { const int br = r / 256, q = r % 256, kb = q / 32, nb = q % 32; const float* w = a.in[8 + br] + (size_t)l * 512 * D;
            conv_item(w, D, nb * 32, kb * 64, nullptr, (bf16_t*)(wl + W_BR), 512, br * 1024 + nb * 32, scr, lane); continue; } r -= I_BR;
        if (r < I_OUT) { const int kb = r / 32, nb = r % 32; conv_item(a.in[11] + (size_t)l * D * D, D, nb * 32, kb * 64, nullptr, (bf16_t*)(wl + W_OUT), D, nb * 32, scr, lane); continue; } r -= I_OUT;
        if (r < I_GU) { const int kb = r / 176, nb = r % 176; const int n0 = nb * 32, pn = n0 >> 8, bj = (n0 >> 7) & 1, j = n0 & 127;
            conv_item(a.in[13] + (size_t)l * D * 2 * DFF, 2 * DFF, bj * DFF + 128 * pn + j, kb * 64, a.in[12] + l * D, (bf16_t*)(wl + W_GU), D, n0, scr, lane); continue; } r -= I_GU;
        { const int kb = r / 32, nb = r % 32; conv_item(a.in[14] + (size_t)l * DFF * D, D, nb * 32, kb * 64, nullptr, (bf16_t*)(wl + W_DN), DFF, nb * 32, scr, lane); }
    }
}

DI void prologue(const Args& a, LAS unsigned char* lds, int gw, int NGW, int wave, int lane) {
    unsigned char* ws = a.ws;
    if (blockIdx.x == 0 && wave == 0 && lane < 16) {
        const int l = lane >> 3, q = lane & 7; unsigned* tab = (unsigned*)(ws + WS_ORDER) + (l * 8 + q) * 384; int ia = 0, ic0 = 0, ic1 = 0, pos = 0;
        int nh[2];
#pragma unroll
        for (int j = 0; j < 2; ++j) { const float bfv = a.in[3][l * 8 + ((2 * q + j) & 7)]; const float rate = 64.0f * __builtin_amdgcn_logf(1.0f + __builtin_amdgcn_exp2f((0.5f - bfv) * LOG2E)); float n = 82.0f / rate + 6.0f; n = n > 300.f ? 300.f : n; nh[j] = (int)n; }
        int ib = 0;
        while (ia < 128 || ic0 < 64 || ic1 < 64 || ib < 128) {
            const int t0 = 4 * (64 - ic0), t1 = 4 * (64 - ic1);
            const int ca = ia < 128 ? 48 * (128 - ia) : -1, c0 = ic0 < 64 ? 24 * (t0 < nh[0] ? t0 : nh[0]) : -1, c1 = ic1 < 64 ? 24 * (t1 < nh[1] ? t1 : nh[1]) : -1, cbb = ib < 128 ? 200 : -1;
            if (ca >= c0 && ca >= c1 && ca >= cbb) { const int qa = 127 - ia; tab[pos++] = (0u << 28) | ((unsigned)(q >> 2) << 24) | ((unsigned)(q & 3) << 16) | (unsigned)qa; ++ia; }
            else if (c0 >= c1 && c0 >= cbb) { const int qc = 63 - ic0, bh = 2 * q; tab[pos++] = (2u << 28) | ((unsigned)(bh >> 3) << 24) | ((unsigned)(bh & 7) << 16) | (unsigned)qc; ++ic0; }
            else if (c1 >= cbb) { const int qc = 63 - ic1, bh = 2 * q + 1; tab[pos++] = (2u << 28) | ((unsigned)(bh >> 3) << 24) | ((unsigned)(bh & 7) << 16) | (unsigned)qc; ++ic1; }
            else { const int qb = ib / 2, bh = 2 * q + (ib & 1); tab[pos++] = (1u << 28) | ((unsigned)(bh >> 3) << 24) | ((unsigned)(bh & 7) << 16) | (unsigned)qb; ++ib; }
        }
    }
    conv_weights(a, lds, 0, gw, NGW, wave, lane);
    const float* x = a.in[0]; bf16_t* XB = (bf16_t*)(ws + WS_XB); float* rss0 = (float*)(ws + WS_CTL) + CW_RSS;
    for (int mrow = gw; mrow < M; mrow += 2 * NGW) {
        const int mrow2 = mrow + NGW; const bool has2 = mrow2 < M;
        const f32x4* xr = (const f32x4*)(x + (size_t)mrow * D) + lane; const f32x4* xr2 = (const f32x4*)(x + (size_t)(has2 ? mrow2 : mrow) * D) + lane;
        f32x4 xv[4], xw[4];
#pragma unroll
        for (int j = 0; j < 4; ++j) { xv[j] = __builtin_nontemporal_load(xr + 64 * j); xw[j] = __builtin_nontemporal_load(xr2 + 64 * j); }
        unsigned long long* o8 = (unsigned long long*)(XB + (size_t)mrow * D) + lane; unsigned long long* o82 = (unsigned long long*)(XB + (size_t)mrow2 * D) + lane; float s = 0.f, s2 = 0.f;
#pragma unroll
        for (int j = 0; j < 4; ++j) { const f32x4 v = xv[j]; s += (v.x * v.x + v.y * v.y) + (v.z * v.z + v.w * v.w);
            o8[64 * j] = (unsigned long long)pk2(v.x, v.y) | ((unsigned long long)pk2(v.z, v.w) << 32); }
        if (has2) {
#pragma unroll
            for (int j = 0; j < 4; ++j) { const f32x4 v = xw[j]; s2 += (v.x * v.x + v.y * v.y) + (v.z * v.z + v.w * v.w);
                o82[64 * j] = (unsigned long long)pk2(v.x, v.y) | ((unsigned long long)pk2(v.z, v.w) << 32); } }
        s = wave_sum(s); s2 = wave_sum(s2);
        if (lane == 0) { ((unsigned*)rss0)[mrow] = (unsigned)(fminf(s, 1.6e7f) * 256.0f + 0.5f); if (has2) ((unsigned*)rss0)[mrow2] = (unsigned)(fminf(s2, 1.6e7f) * 256.0f + 0.5f); }
    }
}

DI void scan_phase(const Args& a, LAS unsigned char* lds) {
    if (blockIdx.x >= 16) return;
    const int seq = blockIdx.x, b = seq >> 3, h = seq & 7, tid = opaque_tid(), lane = tid & 63, wave = tid >> 6;
    const float* LF = (const float*)(a.ws + WS_LF); float* CK = (float*)(a.ws + WS_CK) + (size_t)seq * SEQ; u32x4* KX = (u32x4*)(a.ws + WS_KX) + (size_t)seq * SEQ;
    LAS float* wt = (LAS float*)lds;
    float v[32]; float run = 0.f;
#pragma unroll
    for (int j = 0; j < 32; ++j) { run += LF[((size_t)b * SEQ + tid * 32 + j) * 8 + h]; v[j] = run; }
    float inc = run;
#pragma unroll
    for (int o = 1; o < 64; o <<= 1) { const float t = __shfl_up(inc, o); if (lane >= o) inc += t; }
    if (lane == 63) wt[wave] = inc;
    __syncthreads();
    float base = inc - run;
    for (int w = 0; w < wave; ++w) base += wt[w];
#pragma unroll
    for (int j = 0; j < 32; ++j) { const float c = v[j] + base; CK[tid * 32 + j] = c;
        const float x = -c; const unsigned h1 = f2bf(x); const float r1 = x - __uint_as_float(h1 << 16); const unsigned h2 = f2bf(r1); const float r2 = r1 - __uint_as_float(h2 << 16); const unsigned h3 = f2bf(r2);
        KX[tid * 32 + j] = (u32x4){h1 | (h2 << 16), h3, 0u, 0u}; }
    __syncthreads();
}

DI void final_phase(const Args& a, int gw, int NGW, int lane) {
    const float* rss = (const float*)(a.ws + WS_CTL) + CW_RSS + 4 * (size_t)M; const f32x4* gf = (const f32x4*)a.in[15] + lane; const bf16_t* XB = (const bf16_t*)(a.ws + WS_XB);
    f32x4 gv[4];
#pragma unroll
    for (int j = 0; j < 4; ++j) gv[j] = gf[64 * j];
    for (int mrow = gw; mrow < M; mrow += NGW) {
        const float rs = pg8::rstd_of(rss, mrow);
        f32x4* xr = (f32x4*)(a.out + (size_t)mrow * D) + lane; const u32x2* xb = (const u32x2*)(XB + (size_t)mrow * D) + lane;
        u32x2 wv[4];
#pragma unroll
        for (int j = 0; j < 4; ++j) wv[j] = xb[64 * j];
#pragma unroll
        for (int j = 0; j < 4; ++j) { const u32x2 w = wv[j]; f32x4 v = (f32x4){__uint_as_float(w.x << 16), __uint_as_float(w.x & 0xffff0000u), __uint_as_float(w.y << 16), __uint_as_float(w.y & 0xffff0000u)}; v = v * rs * gv[j]; __builtin_nontemporal_store(v, xr + 64 * j); }
    }
}

__global__ void __launch_bounds__(NWAVES * 64, 2) fwd_kernel(Args a) {
    extern __shared__ __attribute__((aligned(16))) unsigned char lds_raw[];
    LAS unsigned char* lds = (LAS unsigned char*)lds_raw;
    volatile LAS unsigned* bst = (volatile LAS unsigned*)(lds + LDS_BYTES - 16);
    if (threadIdx.x < 4) bst[threadIdx.x] = 0u;
    __syncthreads();
    XcdBarrier xbar; xbar.bar = (unsigned*)(a.ws + WS_CTL) + CW_BAR; xbar.x = 0; xbar.st = bst;
    for (int ph = a.ph_lo; ph < a.ph_hi; ++ph) {
        int G = gridDim.x, bx = blockIdx.x; __attribute__((address_space(1))) unsigned char* wsg = (__attribute__((address_space(1))) unsigned char*)a.ws;
        asm volatile("" : "+s"(G), "+s"(bx), "+s"(wsg));
        unsigned char* ws = (unsigned char*)wsg;
        const int vcu = (G % 8 == 0) ? (bx % 8) * (G / 8) + bx / 8 : bx;
        const int NGW = G * NWAVES;
        const int tid = opaque_tid(), lane = tid & 63, wave = __builtin_amdgcn_readfirstlane(tid >> 6); const int gw = vcu * NWAVES + wave;
        float* rssb = (float*)(ws + WS_CTL) + CW_RSS;
        bf16_t* XB = (bf16_t*)(ws + WS_XB); bf16_t* Qp = (bf16_t*)(ws + WS_QP); bf16_t* Kp = (bf16_t*)(ws + WS_KP); bf16_t* Vp = (bf16_t*)(ws + WS_VP);
        bf16_t* Mg = (bf16_t*)(ws + WS_MG); bf16_t* Gt = (bf16_t*)(ws + WS_G); bf16_t* HID = (bf16_t*)(ws + WS_HID);
        if (ph == 0) {
            { unsigned* ctl = (unsigned*)(ws + WS_CTL); const int gt = gw * 64 + lane, GT = NGW * 64;
              for (int i = gt; i < 12288; i += GT) ctl[i] = 0u;
              for (int i = CW_RSS + M + gt; i < CW_RSS + 5 * M; i += GT) ctl[i] = 0u; }
            if (PH_MASK & 256) prologue(a, lds, gw, NGW, wave, lane); }
        else if (ph == N_PHASES - 1) final_phase(a, gw, NGW, lane);
        else {
            const int l = (ph - 1) / 8, k = (ph - 1) % 8;
            unsigned char* wl = ws + WS_W + (size_t)l * W_LAYER;
            const float* rs_in = rssb + (size_t)(2 * l) * M; float* rs_mid = rssb + (size_t)(2 * l + 1) * M; float* rs_out = rssb + (size_t)(2 * l + 2) * M;
            if (k == 0 && (PH_MASK & 1)) {
                pg8::Gemm g{XB, (const bf16_t*)(wl + W_QKV), M, NQKV, D, D, D}; pg8::StaticOrder S; S.init(M, NQKV, G, bx);
                pg8::EpiQKV E{Qp, rs_in, (float*)(ws + WS_LF), a.in[3] + l * 8, (unsigned*)(ws + WS_CTL) + CW_NRM + 64 * l};
                pg8::gemm_phase<pg8::EpiQKV, pg8::StaticOrder, true>(lds, g, S, E);
            } else if (k == 1 && (PH_MASK & 2)) {
                if (l == 0 && bx >= 16) { const int w2 = __builtin_amdgcn_readfirstlane(opaque_tid() >> 6); conv_weights(a, lds, 1, (bx - 16) * NWAVES + w2, (G - 16) * NWAVES, w2, opaque_tid() & 63); }
                scan_phase(a, lds);
            } else if (k == 2 && (PH_MASK & 4)) {
                att::Params P{Qp, Kp, Vp, (const float*)(ws + WS_CK), (const bf16_t*)(ws + WS_KX), a.in[6], a.in[7] + (size_t)l * 192 * 8, a.in[4] + l * 256, a.in[5] + l * 128,
                              0.8f - 0.6f * expf(-0.3f * (float)l), (unsigned*)(ws + WS_CTL) + CW_QUEUE + 128 * l, (const unsigned*)(ws + WS_ORDER) + l * 8 * 384, (const unsigned*)(ws + WS_CTL) + CW_NRM + 64 * l};
                att::attn_phase(P, (char*)lds_raw);
            } else if (k == 3 && (PH_MASK & 8)) {
                pg8::Gemm g{XB, (const bf16_t*)(wl + W_G), M, 3072, D, D, D}; pg8::StaticOrder S; S.init(M, 3072, G, bx);
                pg8::EpiGate E{Gt, rs_in};
                pg8::gemm_phase<pg8::EpiGate, pg8::StaticOrder, true>(lds, g, S, E);
            } else if (k == 4 && (PH_MASK & 16)) {
                pg8::Gemm g{Qp, (const bf16_t*)(wl + W_BR), M, 3072, 512, PITCH, 512}; pg8::BranchOrder S; S.init(M, G, bx);
                pg8::EpiBranch3 E{Gt, Mg};
                pg8::gemm_phase<pg8::EpiBranch3, pg8::BranchOrder, true>(lds, g, S, E);
            } else if (k == 5 && (PH_MASK & 32)) {
                pg8::Gemm g{Mg, (const bf16_t*)(wl + W_OUT), M, D, D, D, D}; pg8::StaticOrder S; S.init(M, D, G, bx);
                pg8::EpiResid E{l == 0 ? a.in[0] : (const float*)nullptr, XB, (unsigned*)rs_mid};
                pg8::gemm_phase<pg8::EpiResid, pg8::StaticOrder, true>(lds, g, S, E);
            } else if (k == 6 && (PH_MASK & 64)) {
                pg8::Gemm g{XB, (const bf16_t*)(wl + W_GU), M, 2 * DFF, D, D, D}; pg8::StaticOrder S; S.init(M, 2 * DFF, G, bx);
                pg8::EpiSwiglu E{HID, rs_mid};
                pg8::gemm_phase<pg8::EpiSwiglu, pg8::StaticOrder, true>(lds, g, S, E);
            } else if (PH_MASK & 128) {
                pg8::Gemm g{HID, (const bf16_t*)(wl + W_DN), M, D, DFF, DFF, DFF}; pg8::StaticOrder S; S.init(M, D, G, bx);
                pg8::EpiResid E{(const float*)nullptr, XB, (unsigned*)rs_out};
                pg8::gemm_phase<pg8::EpiResid, pg8::StaticOrder, true>(lds, g, S, E);
            }
        }
        if (ph + 1 < a.ph_hi) { if (ph == 0) { cg::this_grid().sync(); xbar = xcd_barrier_post((unsigned*)(a.ws + WS_CTL) + CW_BAR, bst); } else xcd_barrier(xbar); }
    }
}

extern "C" void kernel_launch(void* const* d_in, const int* in_sizes, int n_in, void* d_out, int out_size, void* d_ws, size_t ws_size, hipStream_t stream) {
    static int grid = 0;
    if (grid == 0) {
        if (n_in != 16 || out_size != M * D || ws_size < WS_END) { fprintf(stderr, "kernel_launch: unexpected shapes (n_in %d out %d ws %zu)\n", n_in, out_size, ws_size); grid = -1; return; }
        int dev = 0, cus = 0, per_cu = 0;
        hipGetDevice(&dev); hipDeviceGetAttribute(&cus, hipDeviceAttributeMultiprocessorCount, dev);
        hipFuncSetAttribute((const void*)fwd_kernel, hipFuncAttributeMaxDynamicSharedMemorySize, LDS_BYTES);
        hipOccupancyMaxActiveBlocksPerMultiprocessor(&per_cu, (const void*)fwd_kernel, NWAVES * 64, LDS_BYTES);
        (void)hipGetLastError();
        grid = cus * (per_cu < 1 ? 1 : 1);
    }
    if (grid < 0) return;
    Args a{};
    for (int i = 0; i < 16; ++i) a.in[i] = (const float*)d_in[i];
    a.out = (float*)d_out; a.ws = (unsigned char*)d_ws;
#if MK_ONE_LAUNCH
    a.ph_lo = 0; a.ph_hi = N_PHASES;
    void* args[] = {&a};
    hipError_t e = hipLaunchCooperativeKernel((const void*)fwd_kernel, dim3(grid), dim3(NWAVES * 64), args, LDS_BYTES, stream);
    if (e != hipSuccess) fprintf(stderr, "cooperative launch failed: %s (grid %d)\n", hipGetErrorString(e), grid);
#else
    for (int ph = 0; ph < N_PHASES; ++ph) { a.ph_lo = ph; a.ph_hi = ph + 1; hipLaunchKernelGGL(fwd_kernel, dim3(grid), dim3(NWAVES * 64), LDS_BYTES, stream, a); }
#endif
}
```

```cpp
#include <hip/hip_runtime.h>
#include <hip/hip_cooperative_groups.h>
#include <hip/hip_bf16.h>
#include <cstdio>
#include <cstdint>
#include <cmath>
namespace cg = cooperative_groups;

#ifndef PH_MASK
#define PH_MASK 0x1ff
#endif
#ifndef MK_ONE_LAUNCH
#define MK_ONE_LAUNCH 1
#endif

#define LAS __attribute__((address_space(3)))
#define DI __device__ __forceinline__
typedef unsigned short bf16_t;
typedef short bf16x8 __attribute__((ext_vector_type(8)));
typedef short s16x4 __attribute__((ext_vector_type(4)));
typedef float f32x4 __attribute__((ext_vector_type(4)));
typedef float f32x16 __attribute__((ext_vector_type(16)));
typedef unsigned u32x4 __attribute__((ext_vector_type(4)));
typedef unsigned u32x2 __attribute__((ext_vector_type(2)));
typedef float f32x2_t __attribute__((ext_vector_type(2)));
typedef __bf16 bf16x2_t __attribute__((ext_vector_type(2)));
DI int opaque_tid() { int t = threadIdx.x; asm volatile("" : "+v"(t)); return t; }

constexpr int D = 1024, BATCH = 2, SEQ = 16384, DEPTH = 2, M = BATCH * SEQ;
constexpr int INW = 7688, DFF = 2816;
constexpr int PITCH = 1536;
constexpr int NQKV = 4864;
constexpr float RMS_EPS = 1e-6f;
constexpr float LOG2E = 1.4426950408889634f;
constexpr float C2 = 0.125f * LOG2E;

constexpr size_t MiB = 1u << 20;
constexpr size_t WS_CTL = 0, CTL_BYTES = 1 * MiB;
constexpr size_t WS_ORDER = 1 * MiB;
constexpr size_t WS_LF = 2 * MiB;
constexpr size_t WS_CK = 3 * MiB;
constexpr size_t WS_KX = 4 * MiB;
constexpr size_t WS_W = 8 * MiB;
constexpr size_t W_QKV = 0, W_G = 10 * MiB, W_BR = 16 * MiB, W_OUT = 19 * MiB, W_GU = 21 * MiB, W_DN = 32 * MiB, W_LAYER = 38 * MiB;
constexpr size_t WS_XB = 84 * MiB;
constexpr size_t WS_QP = 148 * MiB, WS_KP = 244 * MiB, WS_VP = 340 * MiB;
constexpr size_t WS_MG = 436 * MiB;
constexpr size_t WS_G = WS_KP;
constexpr size_t WS_HID = WS_KP;
constexpr size_t WS_END = 500 * MiB;
static_assert(WS_W + 2 * W_LAYER <= WS_XB, "weights fit");
constexpr int CW_QUEUE = 0;
constexpr int CW_BAR = 8192;
constexpr int CW_NRM = 1024;
constexpr int CW_RSS = 65536;

constexpr int NUNITS = 3072;

namespace pg8 {
constexpr int BM = 256, BK = 64, HALF = 128, HTB = HALF * BK * 2, STAGE_BYTES = 8 * HTB, NXCD = 8, WGM = 8;
__host__ __device__ __forceinline__ int lds_byte(int r, int c) { const int st = (r >> 4) * 2 + (c >> 5), rr = r & 15, cc = c & 31, ob = rr * 64 + cc * 2; return st * 1024 + (ob ^ (((ob >> 9) & 1) << 5)); }
__host__ __device__ __forceinline__ void stage_rc(int b, int& R, int& C) { const int st = b / 1024, sb = b % 1024, swz = sb ^ (((sb >> 9) & 1) << 5); R = (st >> 1) * 16 + swz / 64; C = (st & 1) * 32 + (swz % 64) / 2; }
__host__ __device__ __forceinline__ int perm32(int rho) { const int n = rho >> 4, i = rho & 15; return 8 * (i >> 2) + 4 * n + (i & 3); }

struct Unit { int pm, pn, aoff; };
struct Gemm { const bf16_t* A; const bf16_t* Bt; int M, N, K, lda, ldb; };

struct StaticOrder {
    int nM, nN, nwg, G, c;
    __device__ void init(int M_, int N_, int G_, int c_) { nM = M_ / BM; nN = N_ / BM; nwg = nM * nN; G = G_; c = c_; }
    __device__ bool tile(long L, int& pm, int& pn) const {
        if (L >= nwg) return false;
        int wgid = (int)L; { const int q = nwg / NXCD, r = nwg % NXCD, xcd = wgid % NXCD, off = wgid / NXCD; wgid = (xcd < r ? xcd * (q + 1) : r * (q + 1) + (xcd - r) * q) + off; }
        const int nig = WGM * nN, gid = wgid / nig, fm = gid * WGM, gsz = (nM - fm) < WGM ? (nM - fm) : WGM;
        pm = fm + ((wgid % nig) % gsz); pn = (wgid % nig) / gsz; return true;
    }
    __device__ bool next(int i, Unit& u) const { u.aoff = 0; return tile((long)i * G + c, u.pm, u.pn); }
};
struct BranchOrder {
    StaticOrder s;
    __device__ void init(int M_, int G_, int c_) { s.init(M_, 1024, G_, c_); }
    __device__ bool next(int i, Unit& u) const {
        const int br = i % 3; int pm, pn;
        if (!s.tile((long)(i / 3) * s.G + s.c, pm, pn)) return false;
        u.pm = pm; u.pn = br * 4 + pn; u.aoff = br * 512 * 2; return true;
    }
};

__device__ __forceinline__ unsigned cvt_pk_bf16(float lo, float hi) { unsigned r; asm volatile("v_cvt_pk_bf16_f32 %0, %1, %2" : "=v"(r) : "v"(lo), "v"(hi)); return r; }

template <class Epi, class Sched, bool ALIGN_EPI>
__device__ __forceinline__ void gemm_phase(LAS unsigned char* lds, const Gemm g, const Sched& S, const Epi& E) {
    const int tid = opaque_tid(), wid = __builtin_amdgcn_readfirstlane(tid >> 6), lane = tid & 63, wr = wid >> 2, wc = wid & 3, fr = lane & 15, fq = lane >> 4;
    const int K = g.K, nt = K / BK;
    unsigned voffA[2], voffB[2];
#pragma unroll
    for (int i = 0; i < 2; ++i) { int R, C; stage_rc(tid * 16 + i * 8192, R, C); const int Rb = Epi::PERM ? ((R & ~31) + perm32(R & 31)) : R;
        voffA[i] = (unsigned)(R * g.lda + C) * 2u; voffB[i] = (unsigned)(Rb * g.ldb + C) * 2u; }
    const size_t kstep = (size_t)(BK * 2);
    const size_t hstepA = (size_t)HALF * g.lda * 2, hstepB = (size_t)HALF * g.ldb * 2;
    const size_t tstepA = 2 * hstepA, tstepB = 2 * hstepB;
    const unsigned ldsw = (unsigned)wid * 1024u;
    const int aoff = lds_byte(wr * 64 + fr, fq * 8), boff = lds_byte(wc * 32 + fr, fq * 8);
#define PG8_SA(b, h) (((b) * 2 + (h)) * HTB)
#define PG8_SB(b, h) ((4 + (b) * 2 + (h)) * HTB)
#define PG8_STAGE(bufoff, gbase, voff) do { _Pragma("unroll") for (int _i = 0; _i < 2; ++_i) \
        __builtin_amdgcn_global_load_lds((const unsigned*)((const char*)(gbase) + (voff)[_i]), (LAS unsigned*)(lds + (bufoff) + ldsw + _i * 8192), 16, 0, 0); } while (0)
#define PG8_LDA(dst, b, h) do { _Pragma("unroll") for (int m = 0; m < 4; ++m) _Pragma("unroll") for (int k = 0; k < 2; ++k) dst[m][k] = *(const LAS bf16x8*)(lds + PG8_SA(b, h) + aoff + m * 2048 + k * 1024); } while (0)
#define PG8_LDB(dst, b, h) do { _Pragma("unroll") for (int n = 0; n < 2; ++n) _Pragma("unroll") for (int k = 0; k < 2; ++k) dst[n][k] = *(const LAS bf16x8*)(lds + PG8_SB(b, h) + boff + n * 2048 + k * 1024); } while (0)
#define PG8_MMA(ai, bj, At, Bt) do { __builtin_amdgcn_s_setprio(1); _Pragma("unroll") for (int m = 0; m < 4; ++m) _Pragma("unroll") for (int n = 0; n < 2; ++n) _Pragma("unroll") for (int k = 0; k < 2; ++k) \
        acc[ai][bj][m][n] = __builtin_amdgcn_mfma_f32_16x16x32_bf16(Bt[n][k], At[m][k], acc[ai][bj][m][n], 0, 0, 0); __builtin_amdgcn_s_setprio(0); } while (0)
#define PG8_WAIT_V(n) asm volatile("s_waitcnt vmcnt(" #n ")" ::: "memory")
#define PG8_WAIT_L(n) asm volatile("s_waitcnt lgkmcnt(" #n ")" ::: "memory")
#define PG8_BAR __builtin_amdgcn_s_barrier()
#define PG8_SCHED __builtin_amdgcn_sched_barrier(0)
    Unit cur, nxt; int ui = 0;
    if (!S.next(0, cur)) return;
    f32x4 acc[2][2][4][2];
#pragma unroll
    for (int a = 0; a < 2; ++a)
#pragma unroll
        for (int b = 0; b < 2; ++b)
#pragma unroll
            for (int m = 0; m < 4; ++m)
#pragma unroll
                for (int n = 0; n < 2; ++n) acc[a][b][m][n] = (f32x4){0.f, 0.f, 0.f, 0.f};
    bf16x8 At[4][2], B0[2][2], B1[2][2];
    const char* cA = (const char*)g.A + (size_t)cur.pm * tstepA + cur.aoff; const char* cB = (const char*)g.Bt + (size_t)cur.pn * tstepB;
    PG8_STAGE(PG8_SB(0, 0), cB, voffB); PG8_STAGE(PG8_SB(0, 1), cB + hstepB, voffB); PG8_STAGE(PG8_SA(0, 0), cA, voffA); PG8_STAGE(PG8_SA(0, 1), cA + hstepA, voffA);
    if (wr == 1) PG8_BAR;
    PG8_WAIT_V(2); PG8_BAR;
    PG8_STAGE(PG8_SB(1, 0), cB + kstep, voffB); PG8_STAGE(PG8_SA(1, 0), cA + kstep, voffA); PG8_STAGE(PG8_SB(1, 1), cB + hstepB + kstep, voffB);
    PG8_WAIT_V(6); PG8_BAR;
    for (;;) {
        const bool has_next = S.next(ui + 1, nxt);
        const char* nA = has_next ? (const char*)g.A + (size_t)nxt.pm * tstepA + nxt.aoff : cA; const char* nB = has_next ? (const char*)g.Bt + (size_t)nxt.pn * tstepB : cB;
        for (int t = 0; t < nt; t += 2) {
            const bool last = (t == nt - 2);
            const char* a1 = cA + (size_t)(t + 1) * kstep;
            const char* a2 = last ? nA : cA + (size_t)(t + 2) * kstep; const char* b2 = last ? nB : cB + (size_t)(t + 2) * kstep;
            const char* a3 = a2 + kstep; const char* b3 = b2 + kstep;
            PG8_LDB(B0, 0, 0); PG8_LDB(B1, 0, 1); PG8_SCHED; PG8_LDA(At, 0, 0); PG8_STAGE(PG8_SA(1, 1), a1 + hstepA, voffA);
            PG8_WAIT_V(8); PG8_WAIT_L(0); PG8_BAR; PG8_MMA(0, 0, At, B0); PG8_MMA(0, 1, At, B1); PG8_BAR; PG8_SCHED;
            PG8_LDA(At, 0, 1); PG8_STAGE(PG8_SB(0, 0), b2, voffB); PG8_STAGE(PG8_SB(0, 1), b2 + hstepB, voffB); PG8_STAGE(PG8_SA(0, 0), a2, voffA);
            PG8_WAIT_V(8); PG8_WAIT_L(0); PG8_BAR; PG8_MMA(1, 0, At, B0); PG8_MMA(1, 1, At, B1); PG8_BAR; PG8_SCHED;
            PG8_LDB(B0, 1, 0); PG8_LDB(B1, 1, 1); PG8_SCHED; PG8_LDA(At, 1, 0); PG8_STAGE(PG8_SA(0, 1), a2 + hstepA, voffA);
            PG8_WAIT_V(8); PG8_WAIT_L(0); PG8_BAR; PG8_MMA(0, 0, At, B0); PG8_MMA(0, 1, At, B1); PG8_BAR; PG8_SCHED;
            PG8_LDA(At, 1, 1); PG8_STAGE(PG8_SB(1, 0), b3, voffB); PG8_STAGE(PG8_SB(1, 1), b3 + hstepB, voffB); PG8_STAGE(PG8_SA(1, 0), a3, voffA);
            PG8_WAIT_V(8); PG8_WAIT_L(0); PG8_BAR; PG8_MMA(1, 0, At, B0); PG8_MMA(1, 1, At, B1); PG8_BAR; PG8_SCHED;
        }
        if constexpr (ALIGN_EPI) { if (wr == 0) PG8_BAR; }
        bool clear_acc = true;
        if constexpr (Epi::FUSE) clear_acc = E.fused(acc, cur, wr, wc, fr, fq); else E(acc, cur, wr, wc, fr, fq);
        if (!has_next) break;
        if (clear_acc) {
#pragma unroll
        for (int a = 0; a < 2; ++a)
#pragma unroll
            for (int b = 0; b < 2; ++b)
#pragma unroll
                for (int m = 0; m < 4; ++m)
#pragma unroll
                    for (int n = 0; n < 2; ++n) acc[a][b][m][n] = (f32x4){0.f, 0.f, 0.f, 0.f};
        }
        cur = nxt; cA = nA; cB = nB; ++ui;
        if constexpr (ALIGN_EPI) { if (wr == 1) PG8_BAR; }
    }
    PG8_WAIT_V(0);
    if constexpr (!ALIGN_EPI) { if (wr == 0) PG8_BAR; }
    PG8_BAR;
#undef PG8_SA
#undef PG8_SB
#undef PG8_STAGE
#undef PG8_LDA
#undef PG8_LDB
#undef PG8_MMA
#undef PG8_WAIT_V
#undef PG8_WAIT_L
#undef PG8_BAR
#undef PG8_SCHED
}

typedef const f32x4 (&AccRef)[2][2][4][2];
__device__ __forceinline__ float rstd_of(const float* rss, int row) { return __builtin_amdgcn_rsqf((float)((const unsigned*)rss)[row] * (1.0f / (256.0f * 1024.0f)) + RMS_EPS); }
__device__ __forceinline__ float sigmoidf_(float x) { return __builtin_amdgcn_rcpf(1.0f + __builtin_amdgcn_exp2f(-x * LOG2E)); }

__device__ __forceinline__ float bflo(unsigned w) { return __uint_as_float(w << 16); }
__device__ __forceinline__ float bfhi(unsigned w) { return __uint_as_float(w & 0xffff0000u); }
struct EpiQKV {
    static constexpr bool PERM = true, FUSE = false;
    bf16_t* Qp; const float* rss; float* LF; const float* bforget; unsigned* nrm;
    __device__ __forceinline__ void operator()(AccRef acc, const Unit& u, int wr, int wc, int fr, int fq) const {
        const int row0 = u.pm * BM + wr * 64 + fr;
        if (u.pn < 18) {
            const int plane = u.pn / 6, colt = (u.pn % 6) * 256; bf16_t* base = Qp + (size_t)plane * ((WS_KP - WS_QP) / 2);
            const float sc = plane == 0 ? C2 : 1.0f; const int col0 = colt + wc * 32 + 8 * fq;
            const bool donrm = (plane < 2) && (colt >= 1024);
            float nmax[2] = {0.f, 0.f};
#pragma unroll
            for (int ai = 0; ai < 2; ++ai)
#pragma unroll
                for (int m = 0; m < 4; ++m) { const int row = row0 + ai * HALF + m * 16; const float rs = rstd_of(rss, row) * sc; bf16_t* rowp = base + (size_t)row * PITCH + col0;
                    const int bb = row >> 14, sq = row & (SEQ - 1), tt = sq >> 6;
#pragma unroll
                    for (int bj = 0; bj < 2; ++bj) { const f32x4 v0 = acc[ai][bj][m][0] * rs, v1 = acc[ai][bj][m][1] * rs; u32x4 w;
                        w.x = cvt_pk_bf16(v0[0], v0[1]); w.y = cvt_pk_bf16(v0[2], v0[3]); w.z = cvt_pk_bf16(v1[0], v1[1]); w.w = cvt_pk_bf16(v1[2], v1[3]);
                        const int col = col0 + bj * HALF;
                        bf16_t* dst = rowp + bj * HALF;
                        if (plane == 1) dst = base + ((((size_t)(bb * 24 + (col >> 6)) * 256 + tt) * 8 + ((col & 63) >> 3)) * 64 + (sq & 63)) * 8;
                        if (plane == 2) dst = base + (((((size_t)(bb * 48 + (col >> 5)) * 256 + tt) * 4 + ((sq & 63) >> 4)) * 16 + (sq & 15)) * 32 + (col & 31));
                        *(u32x4*)dst = w;
                        if (donrm) { float ss = 0.f;
#pragma unroll
                            for (int j = 0; j < 4; ++j) { const float lo = bflo(w[j]), hi = bfhi(w[j]); ss += lo * lo + hi * hi; }
                            ss += __shfl_xor(ss, 16); ss += __shfl_xor(ss, 32); nmax[bj] = fmaxf(nmax[bj], ss); } } }
            if (donrm) {
#pragma unroll
                for (int bj = 0; bj < 2; ++bj) { float v = nmax[bj];
                    v = fmaxf(v, __shfl_xor(v, 1)); v = fmaxf(v, __shfl_xor(v, 2)); v = fmaxf(v, __shfl_xor(v, 4)); v = fmaxf(v, __shfl_xor(v, 8));
                    const int hc = colt - 1024 + bj * HALF + wc * 32;
                    if (fr == 0 && fq == 0) atomicMax(nrm + (((row0 >= SEQ ? 8 : 0) + (hc >> 6)) * 2 + plane) * 2 + ((hc >> 5) & 1), __float_as_uint(v)); } }
        } else if (wc == 0 && fq == 0) {
            f32x4 b0 = *(const f32x4*)(bforget), b1 = *(const f32x4*)(bforget + 4);
#pragma unroll
            for (int ai = 0; ai < 2; ++ai)
#pragma unroll
                for (int m = 0; m < 4; ++m) { const int row = row0 + ai * HALF + m * 16; const float rs = rstd_of(rss, row);
                    f32x4 z0 = acc[ai][0][m][0] * rs + b0, z1 = acc[ai][0][m][1] * rs + b1, o0, o1;
#pragma unroll
                    for (int j = 0; j < 4; ++j) {
                        o0[j] = fminf(z0[j], 0.f) * LOG2E - __builtin_amdgcn_logf(1.0f + __builtin_amdgcn_exp2f(-fabsf(z0[j]) * LOG2E)); o1[j] = fminf(z1[j], 0.f) * LOG2E - __builtin_amdgcn_logf(1.0f + __builtin_amdgcn_exp2f(-fabsf(z1[j]) * LOG2E)); }
                    *(f32x4*)(LF + (size_t)row * 8) = o0; *(f32x4*)(LF + (size_t)row * 8 + 4) = o1; }
        }
    }
};
struct EpiGate {
    static constexpr bool PERM = true, FUSE = false;
    bf16_t* G; const float* rss;
    __device__ __forceinline__ void operator()(AccRef acc, const Unit& u, int wr, int wc, int fr, int fq) const {
        const int row0 = u.pm * BM + wr * 64 + fr, col0 = u.pn * BM + wc * 32 + 8 * fq;
#pragma unroll
        for (int ai = 0; ai < 2; ++ai)
#pragma unroll
            for (int m = 0; m < 4; ++m) { const int row = row0 + ai * HALF + m * 16; const float rs = rstd_of(rss, row); bf16_t* rowp = G + (size_t)row * 3072 + col0;
#pragma unroll
                for (int bj = 0; bj < 2; ++bj) { const f32x4 v0 = acc[ai][bj][m][0] * rs, v1 = acc[ai][bj][m][1] * rs; u32x4 w;
                    w.x = cvt_pk_bf16(sigmoidf_(v0[0]), sigmoidf_(v0[1])); w.y = cvt_pk_bf16(sigmoidf_(v0[2]), sigmoidf_(v0[3]));
                    w.z = cvt_pk_bf16(sigmoidf_(v1[0]), sigmoidf_(v1[1])); w.w = cvt_pk_bf16(sigmoidf_(v1[2]), sigmoidf_(v1[3]));
                    *(u32x4*)(rowp + bj * HALF) = w; } }
    }
};
struct EpiBranch {
    static constexpr bool PERM = true, FUSE = false;
    const bf16_t* G; bf16_t* Mg;
    __device__ __forceinline__ void operator()(AccRef acc, const Unit& u, int wr, int wc, int fr, int fq) const {
        const int br = u.pn >> 2, ct = u.pn & 3;
        const int row0 = u.pm * BM + wr * 64 + fr, col0 = ct * BM + wc * 32 + 8 * fq;
#pragma unroll
        for (int ai = 0; ai < 2; ++ai) {
            u32x4 gwv[4][2], owv[4][2];
#pragma unroll
            for (int m = 0; m < 4; ++m) { const int row = row0 + ai * HALF + m * 16;
                const bf16_t* gp = G + (size_t)row * 3072 + br * 1024 + col0; const bf16_t* mp = Mg + (size_t)row * 1024 + col0;
#pragma unroll
                for (int bj = 0; bj < 2; ++bj) { gwv[m][bj] = *(const u32x4*)(gp + bj * HALF); if (br > 0) owv[m][bj] = *(const u32x4*)(mp + bj * HALF); } }
#pragma unroll
            for (int m = 0; m < 4; ++m) { const int row = row0 + ai * HALF + m * 16; bf16_t* mp = Mg + (size_t)row * 1024 + col0;
#pragma unroll
                for (int bj = 0; bj < 2; ++bj) {
                    const u32x4 gw = gwv[m][bj];
                    f32x4 v0 = acc[ai][bj][m][0], v1 = acc[ai][bj][m][1];
                    v0[0] *= bflo(gw.x); v0[1] *= bfhi(gw.x); v0[2] *= bflo(gw.y); v0[3] *= bfhi(gw.y);
                    v1[0] *= bflo(gw.z); v1[1] *= bfhi(gw.z); v1[2] *= bflo(gw.w); v1[3] *= bfhi(gw.w);
                    if (br > 0) { const u32x4 ow = owv[m][bj];
                        v0[0] += bflo(ow.x); v0[1] += bfhi(ow.x); v0[2] += bflo(ow.y); v0[3] += bfhi(ow.y);
                        v1[0] += bflo(ow.z); v1[1] += bfhi(ow.z); v1[2] += bflo(ow.w); v1[3] += bfhi(ow.w); }
                    u32x4 w; w.x = cvt_pk_bf16(v0[0], v0[1]); w.y = cvt_pk_bf16(v0[2], v0[3]); w.z = cvt_pk_bf16(v1[0], v1[1]); w.w = cvt_pk_bf16(v1[2], v1[3]);
                    *(u32x4*)(mp + bj * HALF) = w; } } }
    }
};
struct EpiBranch3 {
    static constexpr bool PERM = true, FUSE = true;
    const bf16_t* G; bf16_t* Mg;
    __device__ __forceinline__ bool fused(f32x4 (&acc)[2][2][4][2], const Unit& u, int wr, int wc, int fr, int fq) const {
        const int br = u.pn >> 2, ct = u.pn & 3;
        const int row0 = u.pm * BM + wr * 64 + fr, col0 = ct * BM + wc * 32 + 8 * fq;
#pragma unroll
        for (int ai = 0; ai < 2; ++ai) {
            u32x4 gav[4][2], gbv[4][2];
#pragma unroll
            for (int m = 0; m < 4; ++m) { const bf16_t* gp = G + (size_t)(row0 + ai * HALF + m * 16) * 3072 + br * 1024 + col0;
#pragma unroll
                for (int bj = 0; bj < 2; ++bj) { gav[m][bj] = *(const u32x4*)(gp + bj * HALF); if (br < 2) gbv[m][bj] = *(const u32x4*)(gp + 1024 + bj * HALF); } }
#pragma unroll
            for (int m = 0; m < 4; ++m) { bf16_t* mp = Mg + (size_t)(row0 + ai * HALF + m * 16) * 1024 + col0;
#pragma unroll
                for (int bj = 0; bj < 2; ++bj) {
                    const u32x4 ga = gav[m][bj]; float s[8];
                    s[0] = bflo(ga.x); s[1] = bfhi(ga.x); s[2] = bflo(ga.y); s[3] = bfhi(ga.y); s[4] = bflo(ga.z); s[5] = bfhi(ga.z); s[6] = bflo(ga.w); s[7] = bfhi(ga.w);
#pragma unroll
                    for (int j = 0; j < 8; ++j) s[j] = fmaxf(s[j], 1e-18f);
                    if (br < 2) { const u32x4 gb = gbv[m][bj]; float d[8];
                        d[0] = bflo(gb.x); d[1] = bfhi(gb.x); d[2] = bflo(gb.y); d[3] = bfhi(gb.y); d[4] = bflo(gb.z); d[5] = bfhi(gb.z); d[6] = bflo(gb.w); d[7] = bfhi(gb.w);
#pragma unroll
                        for (int j = 0; j < 8; ++j) s[j] *= __builtin_amdgcn_rcpf(fmaxf(d[j], 1e-18f)); }
                    f32x4 v0 = acc[ai][bj][m][0], v1 = acc[ai][bj][m][1];
                    v0[0] *= s[0]; v0[1] *= s[1]; v0[2] *= s[2]; v0[3] *= s[3]; v1[0] *= s[4]; v1[1] *= s[5]; v1[2] *= s[6]; v1[3] *= s[7];
                    if (br < 2) { acc[ai][bj][m][0] = v0; acc[ai][bj][m][1] = v1; }
                    else { u32x4 w; w.x = cvt_pk_bf16(v0[0], v0[1]); w.y = cvt_pk_bf16(v0[2], v0[3]); w.z = cvt_pk_bf16(v1[0], v1[1]); w.w = cvt_pk_bf16(v1[2], v1[3]);
                        *(u32x4*)(mp + bj * HALF) = w; } } } }
        return br == 2;
    }
};
struct EpiResid {
    static constexpr bool PERM = true, FUSE = false;
    const float* xin32; bf16_t* XB; unsigned* rssn;
    __device__ __forceinline__ void operator()(AccRef acc, const Unit& u, int wr, int wc, int fr, int fq) const {
        const int row0 = u.pm * BM + wr * 64 + fr, col0 = u.pn * BM + wc * 32 + 8 * fq;
#pragma unroll
        for (int ai = 0; ai < 2; ++ai) {
            f32x4 xv[4][2][2];
#pragma unroll
            for (int m = 0; m < 4; ++m) { const size_t off = (size_t)(row0 + ai * HALF + m * 16) * 1024 + col0;
#pragma unroll
                for (int bj = 0; bj < 2; ++bj) { const size_t o2 = off + bj * HALF;
                    if (xin32) { xv[m][bj][0] = *(const f32x4*)(xin32 + o2); xv[m][bj][1] = *(const f32x4*)(xin32 + o2 + 4); }
                    else { const u32x4 xw = *(const u32x4*)(XB + o2); xv[m][bj][0] = (f32x4){bflo(xw.x), bfhi(xw.x), bflo(xw.y), bfhi(xw.y)}; xv[m][bj][1] = (f32x4){bflo(xw.z), bfhi(xw.z), bflo(xw.w), bfhi(xw.w)}; } } }
#pragma unroll
            for (int m = 0; m < 4; ++m) { const int row = row0 + ai * HALF + m * 16; const size_t off = (size_t)row * 1024 + col0; float ss = 0.f;
#pragma unroll
                for (int bj = 0; bj < 2; ++bj) { const size_t o2 = off + bj * HALF;
                    const f32x4 x0 = xv[m][bj][0] + acc[ai][bj][m][0], x1 = xv[m][bj][1] + acc[ai][bj][m][1];
                    u32x4 w; w.x = cvt_pk_bf16(x0[0], x0[1]); w.y = cvt_pk_bf16(x0[2], x0[3]); w.z = cvt_pk_bf16(x1[0], x1[1]); w.w = cvt_pk_bf16(x1[2], x1[3]);
                    *(u32x4*)(XB + o2) = w;
                    ss += ((x0[0] * x0[0] + x0[1] * x0[1]) + (x0[2] * x0[2] + x0[3] * x0[3])) + ((x1[0] * x1[0] + x1[1] * x1[1]) + (x1[2] * x1[2] + x1[3] * x1[3])); }
                ss += __shfl_xor(ss, 16); ss += __shfl_xor(ss, 32);
                if (fq == 0) atomicAdd(rssn + row, (unsigned)(fminf(ss, 4.0e6f) * 256.0f + 0.5f)); } }
    }
};
struct EpiSwiglu {
    static constexpr bool PERM = true, FUSE = false;
    bf16_t* H; const float* rss;
    __device__ __forceinline__ void operator()(AccRef acc, const Unit& u, int wr, int wc, int fr, int fq) const {
        const int row0 = u.pm * BM + wr * 64 + fr, col0 = u.pn * 128 + wc * 32 + 8 * fq;
#pragma unroll
        for (int ai = 0; ai < 2; ++ai)
#pragma unroll
            for (int m = 0; m < 4; ++m) { const int row = row0 + ai * HALF + m * 16; const float rs = rstd_of(rss, row);
                float hv[8];
#pragma unroll
                for (int n = 0; n < 2; ++n)
#pragma unroll
                    for (int j = 0; j < 4; ++j) { const float gt = acc[ai][0][m][n][j] * rs, up = acc[ai][1][m][n][j] * rs; hv[n * 4 + j] = gt * sigmoidf_(gt) * up; }
                u32x4 w; w.x = cvt_pk_bf16(hv[0], hv[1]); w.y = cvt_pk_bf16(hv[2], hv[3]); w.z = cvt_pk_bf16(hv[4], hv[5]); w.w = cvt_pk_bf16(hv[6], hv[7]);
                *(u32x4*)(H + (size_t)row * DFF + col0) = w; }
    }
};
}

namespace att {
constexpr int SLOT = 33792;
constexpr int NSLOT = 4, OFF_TAB = NSLOT * SLOT, TAB_BYTES = 8704, OFF_UNIT = OFF_TAB + TAB_BYTES, OFF_VOTE = OFF_UNIT + 64, LDS_BYTES = OFF_VOTE + 128;
typedef LAS const char* lds_cptr;
typedef short v4i16_t __attribute__((ext_vector_type(4)));

DI void glds16(const void* gsrc, unsigned lds_dst) { unsigned keep;
    asm volatile("s_mov_b32 %0, m0\n\ts_mov_b32 m0, %2\n\ts_nop 0\n\tglobal_load_lds_dwordx4 %1, off\n\ts_mov_b32 m0, %0" : "=&s"(keep) : "v"(gsrc), "s"(lds_dst) : "memory"); }
DI unsigned cvtpk(float lo, float hi) { f32x2_t v = {lo, hi}; bf16x2_t b = __builtin_convertvector(v, bf16x2_t); return __builtin_bit_cast(unsigned, b); }
DI s16x4 vtr(lds_cptr p) { return __builtin_bit_cast(s16x4, __builtin_amdgcn_ds_read_tr16_b64_v4i16((LAS v4i16_t*)p)); }
DI float max3f(float a, float b, float c) { float r; asm("v_max3_f32 %0, %1, %2, %3" : "=v"(r) : "v"(a), "v"(b), "v"(c)); return r; }
DI float swapmax(float m) { auto rr = __builtin_amdgcn_permlane32_swap(__float_as_uint(m), __float_as_uint(m), false, false); return fmaxf(__uint_as_float(rr[0]), __uint_as_float(rr[1])); }
DI float swapsum(float m) { auto rr = __builtin_amdgcn_permlane32_swap(__float_as_uint(m), __float_as_uint(m), false, false); return __uint_as_float(rr[0]) + __uint_as_float(rr[1]); }
DI void store_pair16(bf16_t* p_even, int hi, u32x2 a, u32x2 b, bool dry) {
    auto rx = __builtin_amdgcn_permlane32_swap(a.x, b.x, false, false); auto ry = __builtin_amdgcn_permlane32_swap(a.y, b.y, false, false);
    const u32x4 w = (u32x4){(unsigned)rx[0], (unsigned)ry[0], (unsigned)rx[1], (unsigned)ry[1]};
    if (!dry) *(u32x4*)(p_even + 8 * hi) = w;
}
#define ATT_WAIT_BAR() asm volatile("s_waitcnt vmcnt(0) lgkmcnt(0)\n\ts_barrier" ::: "memory")
#define ATT_WAIT_BAR_N(N) asm volatile("s_waitcnt vmcnt(" #N ") lgkmcnt(0)\n\ts_barrier" ::: "memory")

struct Params {
    bf16_t* Qp; const bf16_t* Kp; const bf16_t* Vp; const float* CK; const bf16_t* KX;
    const float* t5; const float* relb; const float* dlam; const float* subg; float lam_init;
    unsigned* counter; const unsigned* order; const unsigned* nrm;
};

template <int KIND> DI void attn_unit(const Params& P, int b, int h, int qb, char* shm, float lam, int& tabtag, bool dry = false) {
    constexpr int NDB = (KIND == 0) ? 4 : 2;
    const int tid = opaque_tid(), lane = tid & 63, r32 = lane & 31, hi = lane >> 5; const int wid = __builtin_amdgcn_readfirstlane(tid >> 6);
    const long rowbase = (long)b * SEQ;
    int qrow0, qoff, T_lo, T_hi, wt_lo, wt_hi; const int m = wid >> 2;
    if (KIND == 0) { qrow0 = qb * 128 + 32 * (wid & 3); qoff = h * 128 + m * 64; T_lo = 0; T_hi = 2 * qb + 1; wt_lo = 0; wt_hi = 2 * qb + ((wid & 3) >> 1); }
    else if (KIND == 1) { qrow0 = qb * 256 + 32 * wid; qoff = 512 + h * 64; const int cq = 4 * qb + (wid >> 1); T_lo = 4 * qb - 8 < 0 ? 0 : 4 * qb - 8; T_hi = 4 * qb + 3; wt_lo = cq - 8 < 0 ? 0 : cq - 8; wt_hi = cq; }
    else { qrow0 = qb * 256 + 32 * wid; qoff = 1024 + h * 64; T_lo = 0; T_hi = 4 * qb + 3; wt_lo = 0; wt_hi = 4 * qb + (wid >> 1); }
    const int kvoff = (KIND == 0) ? h * 128 : qoff;
    const unsigned lds0 = (unsigned)(uintptr_t)shm;
    const lds_cptr shm3 = (lds_cptr)shm;
    const int hk = kvoff >> 6, vb0 = kvoff >> 5;
    const bf16_t* ksrc = P.Kp + ((size_t)(b * 24 + hk) * 256) * 4096 + wid * 512 + lane * 8;
    const bf16_t* vsrc0 = P.Vp + ((size_t)(b * 48 + vb0 + (wid >> 2)) * 256) * 2048 + (wid & 3) * 512 + lane * 8;
    const bf16_t* kxsrc = P.KX + ((size_t)(b * 8 + h) * SEQ + lane) * 8;
#define ATT_DMA(t, so) do { const unsigned sb_ = lds0 + (so); \
        glds16(ksrc + (size_t)(t) * 4096, (unsigned)__builtin_amdgcn_readfirstlane(sb_ + wid * 1024)); \
        if (KIND == 0) glds16(ksrc + (size_t)(t) * 4096 + (size_t)256 * 4096, (unsigned)__builtin_amdgcn_readfirstlane(sb_ + 8192 + wid * 1024)); \
        glds16(vsrc0 + (size_t)(t) * 2048, (unsigned)__builtin_amdgcn_readfirstlane(sb_ + 16384 + wid * 1024)); \
        if (KIND == 0) glds16(vsrc0 + (size_t)(t) * 2048 + (size_t)2 * 256 * 2048, (unsigned)__builtin_amdgcn_readfirstlane(sb_ + 16384 + 8192 + wid * 1024)); \
        if (KIND == 2 && wid == 0) glds16(kxsrc + (size_t)(t) * 64 * 8, (unsigned)__builtin_amdgcn_readfirstlane(sb_ + 32768)); } while (0)
    float cb = 0.f;
    const int want = (KIND << 8) | h;
    if (KIND == 0) { cb = P.t5[15 * 4 + h] * LOG2E;
        if (tabtag != want) for (int i = tid; i < 2175; i += 512) { const int rel = i - 2111; const int n = rel < 0 ? -rel : rel;
            int lg = 36 - __builtin_clz((unsigned)(n | 1)); lg = lg > 15 ? 15 : lg; int idx = n < 8 ? n : lg; idx += rel > 0 ? 16 : 0;
            *(LAS float*)(shm3 + OFF_TAB + i * 4) = P.t5[idx * 4 + h] * LOG2E - cb; } }
    if (KIND == 1) { cb = P.relb[h] * LOG2E;
        if (tabtag != want && tid < 255) { int idx = tid - 191; idx = idx < -128 ? -128 : idx; *(LAS float*)(shm3 + OFF_TAB + tid * 4) = P.relb[(idx + 128) * 8 + h] * LOG2E - cb; } }
    if (KIND != 2) tabtag = want;
    const int NT = T_hi - T_lo + 1;
#define ATT_TILE(i) ((KIND == 2) ? T_hi - (i) : T_lo + (i))
    ATT_DMA(ATT_TILE(0), 0);
    if (NT > 1) ATT_DMA(ATT_TILE(1), SLOT);
    if (NT > 2) ATT_DMA(ATT_TILE(2), 2 * SLOT);
    bf16x8 qr[4];
    { const bf16_t* qp = P.Qp + (rowbase + qrow0 + r32) * PITCH + qoff + hi * 8;
#pragma unroll
      for (int d0 = 0; d0 < 4; ++d0) qr[d0] = *(const bf16x8*)(qp + d0 * 16); }
    float qkmax = 0.f;
    if (KIND == 2) { cb = P.CK[(size_t)(b * 8 + h) * SEQ + qrow0 + r32]; const unsigned* np = P.nrm + (b * 8 + h) * 4; qkmax = (sqrtf(__uint_as_float(np[0]) * __uint_as_float(np[2])) + sqrtf(__uint_as_float(np[1]) * __uint_as_float(np[3]))) * 1.001f + 0.01f; }
    asm volatile("" : "+v"(qr[0]), "+v"(qr[1]), "+v"(qr[2]), "+v"(qr[3]), "+v"(cb), "+v"(qkmax));
    bf16x8 ones = (bf16x8){0, 0, 0, 0, 0, 0, 0, 0}; if (KIND == 2 && hi == 0) { ones[0] = 0x3F80; ones[1] = 0x3F80; ones[2] = 0x3F80; }
    float mhat = 0.f, lsum = 0.f; f32x16 o[NDB]; f32x16 negm;
#pragma unroll
    for (int i = 0; i < NDB; ++i) o[i] = f32x16{};
#pragma unroll
    for (int r = 0; r < 16; ++r) negm[r] = cb;
    const int vlane = ((lane >> 4) & 1) * 32 + (lane & 3) * 8 + (4 * hi + ((lane & 15) >> 2)) * 64;
    LAS unsigned* vote = (LAS unsigned*)(shm3 + OFF_VOTE);
    if (KIND == 2 && tid < 32) vote[tid] = 0u;
    ATT_WAIT_BAR();
    int sc = 0, sd = 3 * SLOT;
    int nt_eff = NT;
#define SBAR() __builtin_amdgcn_sched_barrier(0)
#define PIN(x) asm volatile("" : "+v"(x))
#define MF(a_, b_, c_) __builtin_amdgcn_mfma_f32_32x32x16_bf16(a_, b_, c_, 0, 0, 0)
#define EX(v) __builtin_amdgcn_exp2f(v)
#define ATT_KLD(so_, h_) do { const lds_cptr kb_ = shm3 + (so_) + ((KIND == 0) ? m * 8192 : 0) + hi * 1024 + r32 * 16 + (h_) * 4096; \
        kf[0] = *(const LAS bf16x8*)(kb_); kf[1] = *(const LAS bf16x8*)(kb_ + 512); kf[2] = *(const LAS bf16x8*)(kb_ + 2048); kf[3] = *(const LAS bf16x8*)(kb_ + 2560); } while (0)
#define ATT_XLD(so_) do { if (KIND == 2) { const lds_cptr xb_ = shm3 + (so_) + 32768 + r32 * 16; x0 = *(const LAS bf16x8*)(xb_); x1 = *(const LAS bf16x8*)(xb_ + 512); if (hi) { x0 = (bf16x8){0, 0, 0, 0, 0, 0, 0, 0}; x1 = x0; } } } while (0)
#define ATT_FIX(P0, P1, t_) do { const int tt_ = (t_); \
        if (KIND == 0 && (tt_ * 64 + 63 - qrow0) > -2048) { const lds_cptr tp = shm3 + OFF_TAB + (tt_ * 64 - qrow0 - r32 + 4 * hi + 2111) * 4; \
            _Pragma("unroll") for (int r = 0; r < 16; ++r) { P0[r] += *(LAS const float*)(tp + 4 * ((r & 3) + 8 * (r >> 2))); P1[r] += *(LAS const float*)(tp + 4 * ((r & 3) + 8 * (r >> 2) + 32)); } } \
        if (KIND == 1 && tt_ >= (qrow0 >> 6) - 2) { const lds_cptr tp = shm3 + OFF_TAB + (tt_ * 64 - qrow0 - r32 + 4 * hi + 191) * 4; \
            _Pragma("unroll") for (int r = 0; r < 16; ++r) { P0[r] += *(LAS const float*)(tp + 4 * ((r & 3) + 8 * (r >> 2))); P1[r] += *(LAS const float*)(tp + 4 * ((r & 3) + 8 * (r >> 2) + 32)); } } \
        if (KIND == 2 && tt_ == wt_hi) { const int ql = (qrow0 & 63) + r32; \
            _Pragma("unroll") for (int r = 0; r < 16; ++r) { const int kv = (r & 3) + 8 * (r >> 2) + 4 * hi; if (kv > ql) P0[r] = -INFINITY; if (kv + 32 > ql) P1[r] = -INFINITY; } } \
        if (tt_ < wt_lo || tt_ > wt_hi) { _Pragma("unroll") for (int r = 0; r < 16; ++r) { P0[r] = -INFINITY; P1[r] = -INFINITY; } } } while (0)
#define ATT_DECIDE(P0, P1, rm_) do { if (__any((rm_) > 6.0f)) { const float dl = fmaxf((rm_), 0.f); mhat += dl; const float f = EX(-dl); lsum *= f; \
            _Pragma("unroll") for (int r = 0; r < 16; ++r) { P0[r] -= dl; P1[r] -= dl; negm[r] -= dl; } \
            _Pragma("unroll") for (int i2 = 0; i2 < NDB; ++i2) _Pragma("unroll") for (int r = 0; r < 16; ++r) o[i2][r] *= f; } } while (0)
#define ATT_STEP_BAR(i) do { if ((i) >= 1 && (i) + 2 < NT) { if (KIND == 0) ATT_WAIT_BAR_N(4); else if (KIND == 2 && wid == 0) ATT_WAIT_BAR_N(3); else ATT_WAIT_BAR_N(2); } else ATT_WAIT_BAR(); \
        if ((i) + 3 < NT) ATT_DMA(ATT_TILE((i) + 3), sd); \
        if (KIND == 2 && (i) >= 1) { const u32x4 v0 = *(const LAS u32x4*)(vote + 8 * (((i) - 1) & 3)), v1 = *(const LAS u32x4*)(vote + 8 * (((i) - 1) & 3) + 4); \
            if ((v0.x & v0.y & v0.z & v0.w & v1.x & v1.y & v1.z & v1.w) != 0u && (i) + 1 < nt_eff) nt_eff = (i) + 1; } } while (0)
    f32x16 pa0, pa1, pb0, pb1;
    bf16x8 kf[4], x0, x1;
    ATT_KLD(0, 0); ATT_XLD(0);
    pa0 = MF(kf[0], qr[0], negm); pa1 = MF(kf[1], qr[0], negm); pa0 = MF(kf[2], qr[1], pa0); pa1 = MF(kf[3], qr[1], pa1);
    SBAR(); ATT_KLD(0, 1); SBAR();
    pa0 = MF(kf[0], qr[2], pa0); pa1 = MF(kf[1], qr[2], pa1); pa0 = MF(kf[2], qr[3], pa0); pa1 = MF(kf[3], qr[3], pa1);
    if (KIND == 2) { pa0 = MF(x0, ones, pa0); pa1 = MF(x1, ones, pa1); }
    ATT_FIX(pa0, pa1, ATT_TILE(0));
    { float rm = max3f(pa0[0], pa0[1], pa1[0]), rm2 = max3f(pa0[2], pa0[3], pa1[1]); rm = max3f(rm, pa1[2], pa1[3]);
#pragma unroll
      for (int r = 4; r < 16; r += 4) { rm = max3f(rm, pa0[r], pa0[r + 1]); rm2 = max3f(rm2, pa0[r + 2], pa0[r + 3]); rm = max3f(rm, pa1[r], pa1[r + 1]); rm2 = max3f(rm2, pa1[r + 2], pa1[r + 3]); }
      rm = swapmax(max3f(rm, rm2, rm2)); ATT_DECIDE(pa0, pa1, rm); }
    for (int i = 0; i < nt_eff; ++i) {
        ATT_STEP_BAR(i);
        const int sn = (sc == 3 * SLOT) ? 0 : sc + SLOT;
        const lds_cptr vp = shm3 + sc + 16384 + vlane;
        bf16x8 vq[4]; bf16x8 pw[4]; u32x4 w0, w1; float sacc = 0.f;
#define LDV(j_) do { if ((j_) < 4 * NDB) { const lds_cptr a_ = vp + ((j_) % NDB) * 4096 + ((j_) / NDB) * 1024; const s16x4 lo_ = vtr(a_), hi_ = vtr(a_ + 512); \
            vq[(j_) & 3] = (bf16x8){lo_[0], lo_[1], lo_[2], lo_[3], hi_[0], hi_[1], hi_[2], hi_[3]}; } } while (0)
#define PVM(j_) o[(j_) % NDB] = MF(vq[(j_) & 3], pw[(j_) / NDB], o[(j_) % NDB])
        ATT_KLD(sn, 0); ATT_XLD(sn);
        SBAR();
#define G1(MFMA_, a_, W_, j_) do { MFMA_; pa0[a_] = EX(pa0[a_]); pa0[a_ + 1] = EX(pa0[a_ + 1]); sacc += pa0[a_]; sacc += pa0[a_ + 1]; W_[j_] = cvtpk(pa0[a_], pa0[a_ + 1]); PIN(pa0); PIN(sacc); PIN(W_); SBAR(); } while (0)
        G1(pb0 = MF(kf[0], qr[0], negm), 0, w0, 0);  G1(pb1 = MF(kf[1], qr[0], negm), 2, w0, 1);
        G1(pb0 = MF(kf[2], qr[1], pb0), 4, w0, 2);   G1(pb1 = MF(kf[3], qr[1], pb1), 6, w0, 3);
        ATT_KLD(sn, 1);
        SBAR();
        G1(pb0 = MF(kf[0], qr[2], pb0), 8, w1, 0);   G1(pb1 = MF(kf[1], qr[2], pb1), 10, w1, 1);
        LDV(0); SBAR();
        G1(pb0 = MF(kf[2], qr[3], pb0), 12, w1, 2);
        LDV(1); SBAR();
        G1(pb1 = MF(kf[3], qr[3], pb1), 14, w1, 3);
        LDV(2); SBAR();
#undef G1
        if (KIND == 2) { pb0 = MF(x0, ones, pb0); pb1 = MF(x1, ones, pb1); }
        pw[0] = __builtin_bit_cast(bf16x8, w0); pw[1] = __builtin_bit_cast(bf16x8, w1);
#define E4(a_, W_, j_) do { pa1[a_] = EX(pa1[a_]); pa1[a_ + 1] = EX(pa1[a_ + 1]); sacc += pa1[a_]; sacc += pa1[a_ + 1]; W_[j_] = cvtpk(pa1[a_], pa1[a_ + 1]); } while (0)
        if (NDB == 4) {
            LDV(3); PVM(0); E4(0, w0, 0); PIN(pa1); PIN(sacc); PIN(w0); SBAR();
            LDV(4); PVM(1); E4(2, w0, 1); PIN(pa1); PIN(sacc); PIN(w0); SBAR();
            LDV(5); PVM(2); E4(4, w0, 2); PIN(pa1); PIN(sacc); PIN(w0); SBAR();
            LDV(6); PVM(3); E4(6, w0, 3); PIN(pa1); PIN(sacc); PIN(w0); SBAR();
            LDV(7); PVM(4); E4(8, w1, 0); PIN(pa1); PIN(sacc); PIN(w1); SBAR();
            LDV(8); PVM(5); E4(10, w1, 1); PIN(pa1); PIN(sacc); PIN(w1); SBAR();
            LDV(9); PVM(6); E4(12, w1, 2); PIN(pa1); PIN(sacc); PIN(w1); SBAR();
            LDV(10); PVM(7); E4(14, w1, 3); PIN(pa1); PIN(sacc); PIN(w1); SBAR();
        } else {
            LDV(3); PVM(0); E4(0, w0, 0); E4(2, w0, 1); PIN(pa1); PIN(sacc); PIN(w0); SBAR();
            LDV(4); PVM(1); E4(4, w0, 2); E4(6, w0, 3); PIN(pa1); PIN(sacc); PIN(w0); SBAR();
            LDV(5); PVM(2); E4(8, w1, 0); E4(10, w1, 1); PIN(pa1); PIN(sacc); PIN(w1); SBAR();
            LDV(6); PVM(3); E4(12, w1, 2); E4(14, w1, 3); PIN(pa1); PIN(sacc); PIN(w1); SBAR();
        }
#undef E4
        pw[2] = __builtin_bit_cast(bf16x8, w0); pw[3] = __builtin_bit_cast(bf16x8, w1);
        lsum += sacc;
        ATT_FIX(pb0, pb1, ATT_TILE(i + 1));
        float rm, rm2;
        if (NDB == 4) {
            LDV(11); PVM(8); rm = max3f(pb0[0], pb0[1], pb1[0]); rm2 = max3f(pb0[2], pb0[3], pb1[1]); PIN(rm); PIN(rm2); SBAR();
            LDV(12); PVM(9); rm = max3f(rm, pb1[2], pb1[3]); rm2 = max3f(rm2, pb0[4], pb0[5]); PIN(rm); PIN(rm2); SBAR();
            LDV(13); PVM(10); rm = max3f(rm, pb0[6], pb0[7]); rm2 = max3f(rm2, pb1[4], pb1[5]); PIN(rm); PIN(rm2); SBAR();
            LDV(14); PVM(11); rm = max3f(rm, pb1[6], pb1[7]); rm2 = max3f(rm2, pb0[8], pb0[9]); PIN(rm); PIN(rm2); SBAR();
            LDV(15); PVM(12); rm = max3f(rm, pb0[10], pb0[11]); rm2 = max3f(rm2, pb1[8], pb1[9]); PIN(rm); PIN(rm2); SBAR();
            PVM(13); rm = max3f(rm, pb1[10], pb1[11]); rm2 = max3f(rm2, pb0[12], pb0[13]); PIN(rm); PIN(rm2); SBAR();
            PVM(14); rm = max3f(rm, pb0[14], pb0[15]); rm2 = max3f(rm2, pb1[12], pb1[13]); PIN(rm); PIN(rm2); SBAR();
            PVM(15); rm = max3f(rm, pb1[14], pb1[15]); PIN(rm); SBAR();
        } else {
            LDV(7); PVM(4); rm = max3f(pb0[0], pb0[1], pb1[0]); rm2 = max3f(pb0[2], pb0[3], pb1[1]); rm = max3f(rm, pb1[2], pb1[3]); rm2 = max3f(rm2, pb0[4], pb0[5]); PIN(rm); PIN(rm2); SBAR();
            PVM(5); rm = max3f(rm, pb0[6], pb0[7]); rm2 = max3f(rm2, pb1[4], pb1[5]); rm = max3f(rm, pb1[6], pb1[7]); rm2 = max3f(rm2, pb0[8], pb0[9]); PIN(rm); PIN(rm2); SBAR();
            PVM(6); rm = max3f(rm, pb0[10], pb0[11]); rm2 = max3f(rm2, pb1[8], pb1[9]); rm = max3f(rm, pb1[10], pb1[11]); rm2 = max3f(rm2, pb0[12], pb0[13]); PIN(rm); PIN(rm2); SBAR();
            PVM(7); rm = max3f(rm, pb0[14], pb0[15]); rm2 = max3f(rm2, pb1[12], pb1[13]); rm = max3f(rm, pb1[14], pb1[15]); PIN(rm); PIN(rm2); SBAR();
        }
#undef LDV
#undef PVM
        rm = swapmax(max3f(rm, rm2, rm2));
        if (KIND == 2) {
            const u32x2 kx = *(const LAS u32x2*)(shm3 + sc + 32768);
            const float xk0 = __uint_as_float(kx.x << 16) + __uint_as_float(kx.x & 0xffff0000u) + __uint_as_float(kx.y << 16);
            const float ltot = swapsum(lsum);
            const bool ok = (qkmax + cb + xk0) < (mhat + __builtin_amdgcn_logf(ltot) - 54.0f);
            const bool allok = __all(ok) && !(ATT_TILE(i) > wt_hi);
            if (lane == 0) vote[8 * (i & 3) + wid] = allok ? 1u : 0u;
        }
        if (i + 1 < nt_eff) ATT_DECIDE(pb0, pb1, rm);
        pa0 = pb0; pa1 = pb1;
        sc = sn; sd = (sd == 3 * SLOT) ? 0 : sd + SLOT;
    }
#undef ATT_STEP_BAR
#undef ATT_TILE
#undef ATT_KLD
#undef ATT_XLD
#undef ATT_FIX
#undef ATT_DECIDE
#undef SBAR
#undef PIN
#undef MF
#undef EX
    const float rl = __builtin_amdgcn_rcpf(swapsum(lsum));
    bf16_t* orow = P.Qp + (rowbase + qrow0 + r32) * PITCH + ((KIND == 0) ? h * 128 : qoff);
    ATT_WAIT_BAR();
    if (KIND == 0) {
        LAS float* comb = (LAS float*)shm3 + (size_t)(wid & 3) * 4096 + lane;
        if (m == 1) {
#pragma unroll
            for (int db = 0; db < NDB; ++db)
#pragma unroll
                for (int r = 0; r < 16; ++r) comb[(db * 16 + r) * 64] = o[db][r] * rl;
        }
        ATT_WAIT_BAR();
        if (m == 0) {
            float ss = 0.f;
#pragma unroll
            for (int db = 0; db < NDB; ++db)
#pragma unroll
                for (int r = 0; r < 16; ++r) { const float d = o[db][r] * rl - lam * comb[(db * 16 + r) * 64]; o[db][r] = d; ss += d * d; }
            ss = swapsum(ss);
            const float sc = __builtin_amdgcn_rsqf(ss * (1.0f / 128.0f) + RMS_EPS) * (1.0f - P.lam_init);
#pragma unroll
            for (int db = 0; db < NDB; ++db)
#pragma unroll
                for (int g = 0; g < 4; g += 2) { u32x2 wp[2];
#pragma unroll
                    for (int e = 0; e < 2; ++e) { const f32x4 sg = *(const f32x4*)(P.subg + db * 32 + 8 * (g + e) + 4 * hi); const int r = 4 * (g + e);
                        wp[e].x = cvtpk(o[db][r] * sc * sg[0], o[db][r + 1] * sc * sg[1]); wp[e].y = cvtpk(o[db][r + 2] * sc * sg[2], o[db][r + 3] * sc * sg[3]); }
                    store_pair16(orow + db * 32 + 8 * g, hi, wp[0], wp[1], dry); }
        }
        ATT_WAIT_BAR();
    } else {
#pragma unroll
        for (int db = 0; db < NDB; ++db)
#pragma unroll
            for (int g = 0; g < 4; g += 2) { u32x2 wp[2];
#pragma unroll
                for (int e = 0; e < 2; ++e) { const int r = 4 * (g + e); wp[e].x = cvtpk(o[db][r] * rl, o[db][r + 1] * rl); wp[e].y = cvtpk(o[db][r + 2] * rl, o[db][r + 3] * rl); }
                store_pair16(orow + db * 32 + 8 * g, hi, wp[0], wp[1], dry); }
    }
#undef ATT_DMA
}

DI void attn_phase(const Params& P, char* shm) {
    const int tid = opaque_tid(), lane = tid & 63;
    float lam;
    { const float a = P.dlam[lane] * P.dlam[64 + lane], c = P.dlam[128 + lane] * P.dlam[192 + lane]; float sa = a, sc = c;
#pragma unroll
      for (int o = 1; o < 64; o <<= 1) { sa += __shfl_xor(sa, o); sc += __shfl_xor(sc, o); }
      lam = __builtin_amdgcn_exp2f(sa * LOG2E) - __builtin_amdgcn_exp2f(sc * LOG2E) + P.lam_init; }
    LAS unsigned* su = (LAS unsigned*)((att::lds_cptr)shm + OFF_UNIT);
    int tabtag = -1;
    if (tid >= 256) __builtin_amdgcn_s_setprio(1);
    const unsigned xcd = (unsigned)__builtin_amdgcn_s_getreg((3 << 11) | 20) & 7u;
    for (unsigned k = 0; k < 8; ++k) {
        const unsigned q = (xcd + k) & 7u; unsigned* cnt = P.counter + 16 * q;
        for (;;) {
            if (tid == 0) su[0] = atomicAdd(cnt, 1u);
            ATT_WAIT_BAR();
            const unsigned ui = su[0];
            ATT_WAIT_BAR();
            if (ui >= 384u) break;
            const unsigned e = P.order[q * 384 + ui]; const int kind = e >> 28, b = (e >> 24) & 15, h = (e >> 16) & 255, qb = e & 0xffff;
#if defined(PROBE_REP_A) || defined(PROBE_REP_C)
            { const int reps = (kind == 0) ? PROBE_REP_A : (kind == 2 ? PROBE_REP_C : 1);
              for (int rep = 1; rep < reps; ++rep) { if (kind == 0) attn_unit<0>(P, b, h, qb, shm, lam, P.lam_init > -1.0f); else attn_unit<2>(P, b, h, qb, shm, lam, P.lam_init > -1.0f); ATT_WAIT_BAR(); } }
#endif
            if (kind == 0) attn_unit<0>(P, b, h, qb, shm, lam, tabtag);
            else if (kind == 1) attn_unit<1>(P, b, h, qb, shm, lam, tabtag);
            else attn_unit<2>(P, b, h, qb, shm, lam, tabtag);
            ATT_WAIT_BAR();
        }
    }
    __builtin_amdgcn_s_setprio(0);
}
}

#define XB_TMO      128
#define XB_XCNT(j)  (256  + 64 * (j))
#define XB_XSUB(j)  (1280 + 64 * (j))
#define XB_XGEN(j)  (2304 + 64 * (j))
#define XB_TOP      3328
#define XB_TOPGEN   3392
#define XCD_BAR_WORDS 3456
#define XB_SPIN_CAP (1u << 18)

__device__ __forceinline__ unsigned xb_ld(unsigned* p)              { return __hip_atomic_load(p, __ATOMIC_RELAXED, __HIP_MEMORY_SCOPE_AGENT); }
__device__ __forceinline__ unsigned xb_add(unsigned* p, unsigned v) { return __hip_atomic_fetch_add(p, v, __ATOMIC_RELAXED, __HIP_MEMORY_SCOPE_AGENT); }
__device__ __forceinline__ unsigned xb_xcc_id() { return (unsigned)__builtin_amdgcn_s_getreg((3 << 11) | 20) & 0xFu; }
#define XB_SPIN(cond, bar) do { unsigned _sp = 0; while (cond) { __builtin_amdgcn_s_sleep(1); \
    if ((++_sp & 255u) == 0u) { if (xb_ld(&(bar)[XB_TMO])) break; if (_sp > XB_SPIN_CAP) { atomicAdd(&(bar)[XB_TMO], 1u); break; } } } } while (0)

struct XcdBarrier {
    unsigned* bar; unsigned x;
    volatile LAS unsigned* st;
};

__device__ __forceinline__ XcdBarrier xcd_barrier_post(unsigned* bar, volatile LAS unsigned* st) {
    XcdBarrier b; b.bar = bar; b.x = xb_xcc_id(); b.st = st;
    if (threadIdx.x == 0) (void)xb_add(&bar[XB_XCNT(b.x)], 1u);
    return b;
}
__device__ __forceinline__ void xcd_barrier_complete(unsigned* bar, unsigned x, unsigned& nloc, unsigned& nx) {
    const unsigned G = gridDim.x * gridDim.y * gridDim.z;
    unsigned sum, cnt, mine, sp = 0u;
    for (;;) {
        sum = 0u; cnt = 0u; mine = 0u;
#pragma unroll
        for (unsigned j = 0; j < 16; ++j) { const unsigned c = xb_ld(&bar[XB_XCNT(j)]); sum += c; cnt += (c > 0u) ? 1u : 0u; mine = (j == x) ? c : mine; }
        if (sum == G) break;
        __builtin_amdgcn_s_sleep(1);
        if ((++sp & 255u) == 0u) { if (xb_ld(&bar[XB_TMO])) break; if (sp > XB_SPIN_CAP) { atomicAdd(&bar[XB_TMO], 1u); break; } }
    }
    nloc = mine > 0u ? mine : 1u; nx = cnt > 0u ? cnt : 1u;
}

__device__ __forceinline__ void xcd_barrier(const XcdBarrier& b) {
    asm volatile("s_waitcnt vmcnt(0)" ::: "memory");
    __syncthreads();
    if (threadIdx.x == 0) {
        unsigned* bar = b.bar;
        __builtin_amdgcn_s_waitcnt(0);
        unsigned nloc = b.st[0], nx = b.st[1];
        if (nloc == 0u) { xcd_barrier_complete(bar, b.x, nloc, nx); b.st[0] = nloc; b.st[1] = nx; }
        const unsigned old = xb_add(&bar[XB_XSUB(b.x)], 1u);
        const unsigned gen = old / nloc;
        if (old + 1u == (gen + 1u) * nloc) {
            __builtin_amdgcn_fence(__ATOMIC_RELEASE, "agent");
            asm volatile("s_waitcnt vmcnt(0)" ::: "memory");
            const unsigned og = xb_add(&bar[XB_TOP], 1u);
            const unsigned tg = og / nx;
            if (og + 1u == (tg + 1u) * nx) xb_add(&bar[XB_TOPGEN], 1u);
            else XB_SPIN(xb_ld(&bar[XB_TOPGEN]) == tg, bar);
            __builtin_amdgcn_fence(__ATOMIC_ACQUIRE, "agent");
            xb_add(&bar[XB_XGEN(b.x)], 1u);
            asm volatile("s_waitcnt vmcnt(0)" ::: "memory");
        } else {
            XB_SPIN(xb_ld(&bar[XB_XGEN(b.x)]) == gen, bar);
            __builtin_amdgcn_fence(__ATOMIC_ACQUIRE, "agent");
            asm volatile("s_waitcnt vmcnt(0)" ::: "memory");
        }
    }
    __syncthreads();
}

constexpr int NWAVES = 8;
constexpr int LDS_BYTES = 147456;

struct Args {
    const float* in[16]; float* out; unsigned char* ws; int ph_lo, ph_hi;
};
constexpr int N_PHASES = 18;

DI float wave_sum(float v) {
#pragma unroll
    for (int o = 1; o < 64; o <<= 1) v += __shfl_xor(v, o);
    return v;
}
DI unsigned f2bf(float f) { unsigned u = __builtin_bit_cast(unsigned, f); return (u + 0x7fffu + ((u >> 16) & 1u)) >> 16; }
DI unsigned pk2(float lo, float hi) { return f2bf(lo) | (f2bf(hi) << 16); }

DI void conv_item(const float* W, int ldw, int src_col0, int k0, const float* gv, bf16_t* WT, int ldt, int dst_row0, LAS float* scr, int lane) {
    { f32x4 wv[8]; float gs[8];
#pragma unroll
      for (int i = 0; i < 8; ++i) { const int kk = 8 * i + (lane >> 3); wv[i] = *(const f32x4*)(W + (size_t)(k0 + kk) * ldw + src_col0 + (lane & 7) * 4); gs[i] = gv ? gv[k0 + kk] : 1.0f; }
#pragma unroll
      for (int i = 0; i < 8; ++i) { const int kk = 8 * i + (lane >> 3); LAS float* d = scr + kk * 33 + (lane & 7) * 4; const f32x4 v = wv[i] * gs[i]; d[0] = v.x; d[1] = v.y; d[2] = v.z; d[3] = v.w; } }
    asm volatile("s_waitcnt lgkmcnt(0)" ::: "memory");
    const int c = lane & 7;
#pragma unroll
    for (int j = 0; j < 4; ++j) { const int n = (lane >> 3) + 8 * j; const LAS float* s = scr + (8 * c) * 33 + n;
        u32x4 o; o.x = pk2(s[0 * 33], s[1 * 33]); o.y = pk2(s[2 * 33], s[3 * 33]); o.z = pk2(s[4 * 33], s[5 * 33]); o.w = pk2(s[6 * 33], s[7 * 33]);
        *(u32x4*)(WT + (size_t)(dst_row0 + n) * ldt + k0 + 8 * c) = o; }
    asm volatile("s_waitcnt lgkmcnt(0)" ::: "memory");
}

DI void conv_weights(const Args& a, LAS unsigned char* lds, int l, int gw, int NGW, int wave, int lane) {
    unsigned char* ws = a.ws;
    LAS float* scr = (LAS float*)(lds + wave * 16384);
    constexpr int I_QKV = 9 * 256, I_CF = 256, I_G = 16 * 96, I_BR = 3 * 256, I_OUT = 512, I_GU = 16 * 176, I_DN = 44 * 32;
    constexpr int I_LAYER = I_QKV + I_CF + I_G + I_BR + I_OUT + I_GU + I_DN;
    for (int it = gw; it < I_LAYER; it += NGW) {
        int r = it;
        unsigned char* wl = ws + WS_W + (size_t)l * W_LAYER;
        const float* w_in = a.in[2] + (size_t)l * D * INW; const float* gmix = a.in[1] + l * D;
        if (r < I_QKV) { const int grp = r / 256, q = r % 256, kb = q / 16, nb = q % 16;
            const int srcs[9] = {0, 1536, 3072, 512, 2048, 3584, 1024, 2560, 4096};
            int sc = 0;
#pragma unroll
            for (int i = 0; i < 9; ++i) sc = (grp == i) ? srcs[i] : sc;
            conv_item(w_in, INW, sc + nb * 32, kb * 64, gmix, (bf16_t*)(wl + W_QKV), D, grp * 512 + nb * 32, scr, lane); continue; } r -= I_QKV;
        if (r < I_CF) { bf16_t* dst = (bf16_t*)(wl + W_QKV) + (size_t)(4608 + r) * D;
            for (int k = lane; k < D; k += 64) dst[k] = (r < 8) ? (bf16_t)f2bf(w_in[(size_t)k * INW + 4608 + r] * gmix[k]) : (bf16_t)0; continue; } r -= I_CF;
        if (r < I_G) { const int kb = r / 96, nb = r % 96; conv_item(w_in, INW, 4616 + nb * 32, kb * 64, gmix, (bf16_t*)(wl + W_G), D, nb * 32, scr, lane); continue; } r -= I_G;
        if (r < I_BR) { const int br = r / 256, q = r % 256, kb = q / 32, nb = q % 32; const float* w = a.in[8 + br] + (size_t)l * 512 * D;
            conv_item(w, D, nb * 32, kb * 64, nullptr, (bf16_t*)(wl + W_BR), 512, br * 1024 + nb * 32, scr, lane); continue; } r -= I_BR;
        if (r < I_OUT) { const int kb = r / 32, nb = r % 32; conv_item(a.in[11] + (size_t)l * D * D, D, nb * 32, kb * 64, nullptr, (bf16_t*)(wl + W_OUT), D, nb * 32, scr, lane); continue; } r -= I_OUT;
        if (r < I_GU) { const int kb = r / 176, nb = r % 176; const int n0 = nb * 32, pn = n0 >> 8, bj = (n0 >> 7) & 1, j = n0 & 127;
            conv_item(a.in[13] + (size_t)l * D * 2 * DFF, 2 * DFF, bj * DFF + 128 * pn + j, kb * 64, a.in[12] + l * D, (bf16_t*)(wl + W_GU), D, n0, scr, lane); continue; } r -= I_GU;
        { const int kb = r / 32, nb = r % 32; conv_item(a.in[14] + (size_t)l * DFF * D, D, nb * 32, kb * 64, nullptr, (bf16_t*)(wl + W_DN), DFF, nb * 32, scr, lane); }
    }
}

DI void prologue(const Args& a, LAS unsigned char* lds, int gw, int NGW, int wave, int lane) {
    unsigned char* ws = a.ws;
    if (blockIdx.x == 0 && wave == 0 && lane < 16) {
        const int l = lane >> 3, q = lane & 7; unsigned* tab = (unsigned*)(ws + WS_ORDER) + (l * 8 + q) * 384; int ia = 0, ic0 = 0, ic1 = 0, pos = 0;
        float dep[8];
#pragma unroll
        for (int j = 0; j < 8; ++j) { const float bfv = a.in[3][l * 8 + j]; const float rate = 64.0f * __builtin_amdgcn_logf(1.0f + __builtin_amdgcn_exp2f((0.5f - bfv) * LOG2E)); float n = 82.0f / rate + 6.0f; dep[j] = n > 300.f ? 300.f : n; }
        const int pr = q & 3, cbat = q >> 2; int hsel[2] = {0, 0}, nh[2] = {0, 0};
#pragma unroll
        for (int j = 0; j < 8; ++j) { int rk = 0;
#pragma unroll
            for (int j2 = 0; j2 < 8; ++j2) rk += (dep[j2] < dep[j] || (dep[j2] == dep[j] && j2 < j)) ? 1 : 0;
            if (rk == pr) { hsel[0] = j; nh[0] = (int)dep[j]; }
            if (rk == 7 - pr) { hsel[1] = j; nh[1] = (int)dep[j]; } }
        const int bhc0 = cbat * 8 + hsel[0], bhc1 = cbat * 8 + hsel[1];
        int ib = 0;
        while (ia < 128 || ic0 < 64 || ic1 < 64 || ib < 128) {
            const int t0 = 4 * (64 - ic0), t1 = 4 * (64 - ic1);
            const int ca = ia < 128 ? 48 * (128 - ia) : -1, c0 = ic0 < 64 ? 24 * (t0 < nh[0] ? t0 : nh[0]) : -1, c1 = ic1 < 64 ? 24 * (t1 < nh[1] ? t1 : nh[1]) : -1, cbb = ib < 128 ? 200 : -1;
            if (ca >= c0 && ca >= c1 && ca >= cbb) { const int qa = 127 - ia; tab[pos++] = (0u << 28) | ((unsigned)(q >> 2) << 24) | ((unsigned)(q & 3) << 16) | (unsigned)qa; ++ia; }
            else if (c0 >= c1 && c0 >= cbb) { const int qc = 63 - ic0, bh = bhc0; tab[pos++] = (2u << 28) | ((unsigned)(bh >> 3) << 24) | ((unsigned)(bh & 7) << 16) | (unsigned)qc; ++ic0; }
            else if (c1 >= cbb) { const int qc = 63 - ic1, bh = bhc1; tab[pos++] = (2u << 28) | ((unsigned)(bh >> 3) << 24) | ((unsigned)(bh & 7) << 16) | (unsigned)qc; ++ic1; }
            else { const int qb = ib / 2, bh = 2 * q + (ib & 1); tab[pos++] = (1u << 28) | ((unsigned)(bh >> 3) << 24) | ((unsigned)(bh & 7) << 16) | (unsigned)qb; ++ib; }
        }
    }
    conv_weights(a, lds, 0, gw, NGW, wave, lane);
    const float* x = a.in[0]; bf16_t* XB = (bf16_t*)(ws + WS_XB); float* rss0 = (float*)(ws + WS_CTL) + CW_RSS;
    for (int mrow = gw; mrow < M; mrow += 2 * NGW) {
        const int mrow2 = mrow + NGW; const bool has2 = mrow2 < M;
        const f32x4* xr = (const f32x4*)(x + (size_t)mrow * D) + lane; const f32x4* xr2 = (const f32x4*)(x + (size_t)(has2 ? mrow2 : mrow) * D) + lane;
        f32x4 xv[4], xw[4];
#pragma unroll
        for (int j = 0; j < 4; ++j) { xv[j] = __builtin_nontemporal_load(xr + 64 * j); xw[j] = __builtin_nontemporal_load(xr2 + 64 * j); }
        unsigned long long* o8 = (unsigned long long*)(XB + (size_t)mrow * D) + lane; unsigned long long* o82 = (unsigned long long*)(XB + (size_t)mrow2 * D) + lane; float s = 0.f, s2 = 0.f;
#pragma unroll
        for (int j = 0; j < 4; ++j) { const f32x4 v = xv[j]; s += (v.x * v.x + v.y * v.y) + (v.z * v.z + v.w * v.w);
            o8[64 * j] = (unsigned long long)pk2(v.x, v.y) | ((unsigned long long)pk2(v.z, v.w) << 32); }
        if (has2) {
#pragma unroll
            for (int j = 0; j < 4; ++j) { const f32x4 v = xw[j]; s2 += (v.x * v.x + v.y * v.y) + (v.z * v.z + v.w * v.w);
                o82[64 * j] = (unsigned long long)pk2(v.x, v.y) | ((unsigned long long)pk2(v.z, v.w) << 32); } }
        s = wave_sum(s); s2 = wave_sum(s2);
        if (lane == 0) { ((unsigned*)rss0)[mrow] = (unsigned)(fminf(s, 1.6e7f) * 256.0f + 0.5f); if (has2) ((unsigned*)rss0)[mrow2] = (unsigned)(fminf(s2, 1.6e7f) * 256.0f + 0.5f); }
    }
}

DI void scan_phase(const Args& a, LAS unsigned char* lds) {
    if (blockIdx.x >= 16) return;
    const int seq = blockIdx.x, b = seq >> 3, h = seq & 7, tid = opaque_tid(), lane = tid & 63, wave = tid >> 6;
    const float* LF = (const float*)(a.ws + WS_LF); float* CK = (float*)(a.ws + WS_CK) + (size_t)seq * SEQ; u32x4* KX = (u32x4*)(a.ws + WS_KX) + (size_t)seq * SEQ;
    LAS float* wt = (LAS float*)lds;
    float v[32]; float run = 0.f;
#pragma unroll
    for (int j = 0; j < 32; ++j) { run += LF[((size_t)b * SEQ + tid * 32 + j) * 8 + h]; v[j] = run; }
    float inc = run;
#pragma unroll
    for (int o = 1; o < 64; o <<= 1) { const float t = __shfl_up(inc, o); if (lane >= o) inc += t; }
    if (lane == 63) wt[wave] = inc;
    __syncthreads();
    float base = inc - run;
    for (int w = 0; w < wave; ++w) base += wt[w];
#pragma unroll
    for (int j = 0; j < 32; ++j) { const float c = v[j] + base; CK[tid * 32 + j] = c;
        const float x = -c; const unsigned h1 = f2bf(x); const float r1 = x - __uint_as_float(h1 << 16); const unsigned h2 = f2bf(r1); const float r2 = r1 - __uint_as_float(h2 << 16); const unsigned h3 = f2bf(r2);
        KX[tid * 32 + j] = (u32x4){h1 | (h2 << 16), h3, 0u, 0u}; }
    __syncthreads();
}

DI void final_phase(const Args& a, int gw, int NGW, int lane) {
    const float* rss = (const float*)(a.ws + WS_CTL) + CW_RSS + 4 * (size_t)M; const f32x4* gf = (const f32x4*)a.in[15] + lane; const bf16_t* XB = (const bf16_t*)(a.ws + WS_XB);
    f32x4 gv[4];
#pragma unroll
    for (int j = 0; j < 4; ++j) gv[j] = gf[64 * j];
    for (int mrow = gw; mrow < M; mrow += NGW) {
        const float rs = pg8::rstd_of(rss, mrow);
        f32x4* xr = (f32x4*)(a.out + (size_t)mrow * D) + lane; const u32x2* xb = (const u32x2*)(XB + (size_t)mrow * D) + lane;
        u32x2 wv[4];
#pragma unroll
        for (int j = 0; j < 4; ++j) wv[j] = xb[64 * j];
#pragma unroll
        for (int j = 0; j < 4; ++j) { const u32x2 w = wv[j]; f32x4 v = (f32x4){__uint_as_float(w.x << 16), __uint_as_float(w.x & 0xffff0000u), __uint_as_float(w.y << 16), __uint_as_float(w.y & 0xffff0000u)}; v = v * rs * gv[j]; __builtin_nontemporal_store(v, xr + 64 * j); }
    }
}

__global__ void __launch_bounds__(NWAVES * 64, 2) fwd_kernel(Args a) {
    extern __shared__ __attribute__((aligned(16))) unsigned char lds_raw[];
    LAS unsigned char* lds = (LAS unsigned char*)lds_raw;
    volatile LAS unsigned* bst = (volatile LAS unsigned*)(lds + LDS_BYTES - 16);
    if (threadIdx.x < 4) bst[threadIdx.x] = 0u;
    __syncthreads();
    XcdBarrier xbar; xbar.bar = (unsigned*)(a.ws + WS_CTL) + CW_BAR; xbar.x = 0; xbar.st = bst;
    for (int ph = a.ph_lo; ph < a.ph_hi; ++ph) {
        int G = gridDim.x, bx = blockIdx.x; __attribute__((address_space(1))) unsigned char* wsg = (__attribute__((address_space(1))) unsigned char*)a.ws;
        asm volatile("" : "+s"(G), "+s"(bx), "+s"(wsg));
        unsigned char* ws = (unsigned char*)wsg;
        const int vcu = (G % 8 == 0) ? (bx % 8) * (G / 8) + bx / 8 : bx;
        const int NGW = G * NWAVES;
        const int tid = opaque_tid(), lane = tid & 63, wave = __builtin_amdgcn_readfirstlane(tid >> 6); const int gw = vcu * NWAVES + wave;
        float* rssb = (float*)(ws + WS_CTL) + CW_RSS;
        bf16_t* XB = (bf16_t*)(ws + WS_XB); bf16_t* Qp = (bf16_t*)(ws + WS_QP); bf16_t* Kp = (bf16_t*)(ws + WS_KP); bf16_t* Vp = (bf16_t*)(ws + WS_VP);
        bf16_t* Mg = (bf16_t*)(ws + WS_MG); bf16_t* Gt = (bf16_t*)(ws + WS_G); bf16_t* HID = (bf16_t*)(ws + WS_HID);
        if (ph == 0) {
            { unsigned* ctl = (unsigned*)(ws + WS_CTL); const int gt = gw * 64 + lane, GT = NGW * 64;
              for (int i = gt; i < 12288; i += GT) ctl[i] = 0u;
              for (int i = CW_RSS + M + gt; i < CW_RSS + 5 * M; i += GT) ctl[i] = 0u; }
            if (PH_MASK & 256) prologue(a, lds, gw, NGW, wave, lane); }
        else if (ph == N_PHASES - 1) final_phase(a, gw, NGW, lane);
        else {
            const int l = (ph - 1) / 8, k = (ph - 1) % 8;
            unsigned char* wl = ws + WS_W + (size_t)l * W_LAYER;
            const float* rs_in = rssb + (size_t)(2 * l) * M; float* rs_mid = rssb + (size_t)(2 * l + 1) * M; float* rs_out = rssb + (size_t)(2 * l + 2) * M;
            if (k == 0 && (PH_MASK & 1)) {
                pg8::Gemm g{XB, (const bf16_t*)(wl + W_QKV), M, NQKV, D, D, D}; pg8::StaticOrder S; S.init(M, NQKV, G, bx);
                pg8::EpiQKV E{Qp, rs_in, (float*)(ws + WS_LF), a.in[3] + l * 8, (unsigned*)(ws + WS_CTL) + CW_NRM + 64 * l};
                pg8::gemm_phase<pg8::EpiQKV, pg8::StaticOrder, true>(lds, g, S, E);
            } else if (k == 1 && (PH_MASK & 2)) {
                if (l == 0 && bx >= 16) { const int w2 = __builtin_amdgcn_readfirstlane(opaque_tid() >> 6); conv_weights(a, lds, 1, (bx - 16) * NWAVES + w2, (G - 16) * NWAVES, w2, opaque_tid() & 63); }
                scan_phase(a, lds);
            } else if (k == 2 && (PH_MASK & 4)) {
                att::Params P{Qp, Kp, Vp, (const float*)(ws + WS_CK), (const bf16_t*)(ws + WS_KX), a.in[6], a.in[7] + (size_t)l * 192 * 8, a.in[4] + l * 256, a.in[5] + l * 128,
                              0.8f - 0.6f * expf(-0.3f * (float)l), (unsigned*)(ws + WS_CTL) + CW_QUEUE + 128 * l, (const unsigned*)(ws + WS_ORDER) + l * 8 * 384, (const unsigned*)(ws + WS_CTL) + CW_NRM + 64 * l};
                att::attn_phase(P, (char*)lds_raw);
            } else if (k == 3 && (PH_MASK & 8)) {
                pg8::Gemm g{XB, (const bf16_t*)(wl + W_G), M, 3072, D, D, D}; pg8::StaticOrder S; S.init(M, 3072, G, bx);
                pg8::EpiGate E{Gt, rs_in};
                pg8::gemm_phase<pg8::EpiGate, pg8::StaticOrder, true>(lds, g, S, E);
            } else if (k == 4 && (PH_MASK & 16)) {
                pg8::Gemm g{Qp, (const bf16_t*)(wl + W_BR), M, 3072, 512, PITCH, 512}; pg8::BranchOrder S; S.init(M, G, bx);
                pg8::EpiBranch3 E{Gt, Mg};
                pg8::gemm_phase<pg8::EpiBranch3, pg8::BranchOrder, true>(lds, g, S, E);
            } else if (k == 5 && (PH_MASK & 32)) {
                pg8::Gemm g{Mg, (const bf16_t*)(wl + W_OUT), M, D, D, D, D}; pg8::StaticOrder S; S.init(M, D, G, bx);
                pg8::EpiResid E{l == 0 ? a.in[0] : (const float*)nullptr, XB, (unsigned*)rs_mid};
                pg8::gemm_phase<pg8::EpiResid, pg8::StaticOrder, true>(lds, g, S, E);
            } else if (k == 6 && (PH_MASK & 64)) {
                pg8::Gemm g{XB, (const bf16_t*)(wl + W_GU), M, 2 * DFF, D, D, D}; pg8::StaticOrder S; S.init(M, 2 * DFF, G, bx);
                pg8::EpiSwiglu E{HID, rs_mid};
                pg8::gemm_phase<pg8::EpiSwiglu, pg8::StaticOrder, true>(lds, g, S, E);
            } else if (PH_MASK & 128) {
                pg8::Gemm g{HID, (const bf16_t*)(wl + W_DN), M, D, DFF, DFF, DFF}; pg8::StaticOrder S; S.init(M, D, G, bx);
                pg8::EpiResid E{(const float*)nullptr, XB, (unsigned*)rs_out};
                pg8::gemm_phase<pg8::EpiResid, pg8::StaticOrder, true>(lds, g, S, E);
            }
        }
        if (ph + 1 < a.ph_hi) { if (ph == 0) { cg::this_grid().sync(); xbar = xcd_barrier_post((unsigned*)(a.ws + WS_CTL) + CW_BAR, bst); } else xcd_barrier(xbar); }
    }
}

extern "C" void kernel_launch(void* const* d_in, const int* in_sizes, int n_in, void* d_out, int out_size, void* d_ws, size_t ws_size, hipStream_t stream) {
    static int grid = 0;
    if (grid == 0) {
        if (n_in != 16 || out_size != M * D || ws_size < WS_END) { fprintf(stderr, "kernel_launch: unexpected shapes (n_in %d out %d ws %zu)\n", n_in, out_size, ws_size); grid = -1; return; }
        int dev = 0, cus = 0, per_cu = 0;
        hipGetDevice(&dev); hipDeviceGetAttribute(&cus, hipDeviceAttributeMultiprocessorCount, dev);
        hipFuncSetAttribute((const void*)fwd_kernel, hipFuncAttributeMaxDynamicSharedMemorySize, LDS_BYTES);
        hipOccupancyMaxActiveBlocksPerMultiprocessor(&per_cu, (const void*)fwd_kernel, NWAVES * 64, LDS_BYTES);
        (void)hipGetLastError();
        grid = cus * (per_cu < 1 ? 1 : 1);
    }
    if (grid < 0) return;
    Args a{};
    for (int i = 0; i < 16; ++i) a.in[i] = (const float*)d_in[i];
    a.out = (float*)d_out; a.ws = (unsigned char*)d_ws;
#if MK_ONE_LAUNCH
    a.ph_lo = 0; a.ph_hi = N_PHASES;
    void* args[] = {&a};
    hipError_t e = hipLaunchCooperativeKernel((const void*)fwd_kernel, dim3(grid), dim3(NWAVES * 64), args, LDS_BYTES, stream);
    if (e != hipSuccess) fprintf(stderr, "cooperative launch failed: %s (grid %d)\n", hipGetErrorString(e), grid);
#else
    for (int ph = 0; ph < N_PHASES; ++ph) { a.ph_lo = ph; a.ph_hi = ph + 1; hipLaunchKernelGGL(fwd_kernel, dim3(grid), dim3(NWAVES * 64), LDS_BYTES, stream, a); }
#endif
}
```
